# Optimizing an MI355X kernel written in HIP

```python
import jax, jax.numpy as jnp
from jax import lax

D_MODEL = 2048
BATCH = 2
SEQ = 8192
DEPTH = 1

HEAD_DIM = 64
N_MIX_HEADS = D_MODEL // HEAD_DIM
ATTN_HEADS = 12
RWKV_HEADS = N_MIX_HEADS - ATTN_HEADS
ATTN_DIM = ATTN_HEADS * HEAD_DIM
RWKV_DIM = RWKV_HEADS * HEAD_DIM
DECAY_LORA = 96
ICLR_LORA = 96
GATE_LORA = 256
PROJ_DIM = 3 * RWKV_DIM + DECAY_LORA + ICLR_LORA + GATE_LORA + 3 * ATTN_DIM
DILATION_PAIRS = ((128, 1), (512, 4), (2048, 16))
ATTN_BLOCK = 128
ROPE_THETA = 500000.0
ROT_DIM = HEAD_DIM // 4
D_FF = 5632
ALPHA = (2 * DEPTH) ** 0.25
BETA = (8 * DEPTH) ** -0.25
LN_EPS = 1e-5
GN_EPS = 64e-5

kernel_name = "hymba_rwkv7_dilated_attn_macaron_deepnorm"


def _layer_norm(x, g, b):
    xf = x.astype(jnp.float32)
    mu = jnp.mean(xf, -1, keepdims=True)
    xc = xf - mu
    var = jnp.mean(xc * xc, -1, keepdims=True)
    return (xc * lax.rsqrt(var + LN_EPS) * g + b).astype(x.dtype)


def _swiglu(x, w_gate, w_up, w_down):
    return (jax.nn.silu(x @ w_gate) * (x @ w_up)) @ w_down


def _token_shift(z, mu):
    prev = jnp.pad(z, ((0, 0), (1, 0), (0, 0)))[:, :-1]
    return z + (prev - z) * mu


def _partial_rope(x, positions):
    half = ROT_DIM // 2
    inv_freq = jnp.power(ROPE_THETA, -jnp.arange(half, dtype=jnp.float32) * (2.0 / ROT_DIM))
    ang = positions.astype(jnp.float32)[:, :, None, None] * inv_freq
    cos, sin = jnp.cos(ang), jnp.sin(ang)
    x1, x2, rest = x[..., :half], x[..., half:ROT_DIM], x[..., ROT_DIM:]
    return jnp.concatenate([x1 * cos - x2 * sin, x2 * cos + x1 * sin, rest], -1)


def _wkv7_scan(r, w, k, v, a, b):
    B_, T_, H_, N_ = r.shape

    def step(S, inp):
        r_t, w_t, k_t, v_t, a_t, b_t = inp
        S = (S * w_t[:, :, None, :]
             + jnp.einsum('bhij,bhj->bhi', S, a_t)[..., None] * b_t[:, :, None, :]
             + v_t[..., :, None] * k_t[..., None, :])
        return S, jnp.einsum('bhij,bhj->bhi', S, r_t)

    S0 = jnp.zeros((B_, H_, N_, N_), jnp.float32)
    xs = tuple(jnp.moveaxis(t, 1, 0) for t in (r, w, k, v, a, b))
    _, y = lax.scan(step, S0, xs)
    return jnp.moveaxis(y, 0, 1)


def _rwkv7_mix(r, k, v, w_lo, a_lo, g_lo, mu_r, mu_k, mu_v, mu_w, mu_a, mu_g,
               w0, w2, a0, a2, g2, k_k, k_a, r_k, gn_g, gn_b):
    f32 = jnp.float32
    B_, T_, _ = r.shape
    r = _token_shift(r, mu_r.astype(f32))
    k = _token_shift(k, mu_k.astype(f32))
    v = _token_shift(v, mu_v.astype(f32))
    w_lo = _token_shift(w_lo, mu_w.astype(f32))
    a_lo = _token_shift(a_lo, mu_a.astype(f32))
    g_lo = _token_shift(g_lo, mu_g.astype(f32))
    w = -jax.nn.softplus(-(w0.astype(f32) + jnp.tanh(w_lo) @ w2.astype(f32))) - 0.5
    decay = jnp.exp(-jnp.exp(w))
    a = jax.nn.sigmoid(a0.astype(f32) + a_lo @ a2.astype(f32))
    g = jax.nn.sigmoid(g_lo) @ g2.astype(f32)

    def heads(t):
        return t.reshape(B_, T_, RWKV_HEADS, HEAD_DIM)

    kk = heads(k * k_k.astype(f32))
    kk = kk / jnp.maximum(jnp.sqrt(jnp.sum(kk * kk, -1, keepdims=True)), 1e-12)
    k = k * (1.0 + (a - 1.0) * k_a.astype(f32))
    rh, kh, vh, ah = heads(r), heads(k), heads(v), heads(a)
    y = _wkv7_scan(rh, heads(decay), kh, vh, -kk, kk * ah)
    mu = jnp.mean(y, -1, keepdims=True)
    yc = y - mu
    var = jnp.mean(yc * yc, -1, keepdims=True)
    yn = (yc * lax.rsqrt(var + GN_EPS)).reshape(B_, T_, RWKV_DIM) * gn_g.astype(f32) + gn_b.astype(f32)
    bonus = jnp.sum(rh * kh * r_k.astype(f32), -1, keepdims=True) * vh
    return (yn + bonus.reshape(B_, T_, RWKV_DIM)) * g


def _dilated_branch(q, k, v, window, dilation):
    B_, H_, S_, E_ = q.shape
    span = window // dilation
    unit = dilation * ATTN_BLOCK
    Sp = -(-S_ // unit) * unit
    L = Sp // dilation
    nb = L // ATTN_BLOCK
    pad = ((0, 0), (0, 0), (0, Sp - S_), (0, 0))

    def to_blocks(t):
        t = jnp.pad(t, pad).reshape(B_, H_, L, dilation, E_)
        return jnp.swapaxes(t, 2, 3).reshape(B_, H_, dilation, nb, ATTN_BLOCK, E_)

    def with_prev(t):
        prev = jnp.concatenate([jnp.zeros_like(t[:, :, :, :1]), t[:, :, :, :-1]], axis=3)
        return jnp.concatenate([prev, t], axis=4)

    qb = to_blocks(q)
    kw = with_prev(to_blocks(k))
    vw = with_prev(to_blocks(v))
    s = jnp.einsum('bhrnqe,bhrnke->bhrnqk', qb, kw) * (E_ ** -0.5)
    qi = jnp.arange(ATTN_BLOCK)[:, None] + ATTN_BLOCK
    kj = jnp.arange(2 * ATTN_BLOCK)[None, :]
    rel = qi - kj
    band = (rel >= 0) & (rel <= span)
    valid = band[None] & ((jnp.arange(nb)[:, None, None] > 0) | (kj[None] >= ATTN_BLOCK))
    s = jnp.where(valid, s, -jnp.inf)
    m = jnp.max(s, -1, keepdims=True)
    p = jnp.exp(s - m)
    den = jnp.sum(p, -1, keepdims=True)
    o = jnp.einsum('bhrnqk,bhrnke->bhrnqe', p, vw) / den
    lse = (m + jnp.log(den))[..., 0]
    o = jnp.swapaxes(o.reshape(B_, H_, dilation, L, E_), 2, 3).reshape(B_, H_, Sp, E_)[:, :, :S_]
    lse = jnp.swapaxes(lse.reshape(B_, H_, dilation, L), 2, 3).reshape(B_, H_, Sp)[:, :, :S_]
    return o, lse


def _dilated_attention(q, k, v, positions):
    B_, T_, _ = q.shape

    def heads(t):
        return t.reshape(B_, T_, ATTN_HEADS, HEAD_DIM)

    q = jnp.swapaxes(_partial_rope(heads(q), positions), 1, 2)
    k = jnp.swapaxes(_partial_rope(heads(k), positions), 1, 2)
    v = jnp.swapaxes(heads(v), 1, 2)
    outs, lses = zip(*[_dilated_branch(q, k, v, w, d) for (w, d) in DILATION_PAIRS])
    wts = jax.nn.softmax(jnp.stack(lses), axis=0)
    o = jnp.einsum('gbht,gbhte->bthe', wts, jnp.stack(outs))
    return o.reshape(B_, T_, ATTN_DIM)


def _hybrid_mixer(h, positions, w_in, mu_r, mu_k, mu_v, mu_w, mu_a, mu_g, w0, w2, a0, a2, g2,
                  k_k, k_a, r_k, gn_g, gn_b, w_out):
    proj = (h @ w_in).astype(jnp.float32)
    widths = (RWKV_DIM, RWKV_DIM, RWKV_DIM, DECAY_LORA, ICLR_LORA, GATE_LORA, ATTN_DIM, ATTN_DIM, ATTN_DIM)
    cuts = [sum(widths[:i + 1]) for i in range(len(widths) - 1)]
    r, k, v, w_lo, a_lo, g_lo, qa, ka, va = jnp.split(proj, cuts, axis=-1)
    y_rwkv = _rwkv7_mix(r, k, v, w_lo, a_lo, g_lo, mu_r, mu_k, mu_v, mu_w, mu_a, mu_g,
                        w0, w2, a0, a2, g2, k_k, k_a, r_k, gn_g, gn_b)
    y_attn = _dilated_attention(qa, ka, va, positions)
    y = jnp.concatenate([y_rwkv, y_attn], -1).astype(h.dtype)
    return y @ w_out


def setup_inputs(seed: int = 0) -> dict:
    key = jax.random.key(seed)
    keys = jax.random.split(key, 32)
    counter = iter(range(32))
    f32 = jnp.float32

    def nk():
        return keys[next(counter)]

    def normal(shape, scale):
        return jax.random.normal(nk(), shape, f32) * scale

    def unif(shape, lo, hi):
        return jax.random.uniform(nk(), shape, f32, lo, hi)

    Ld = DEPTH
    x = normal((BATCH, SEQ, D_MODEL), 1.0)
    offsets = jax.random.randint(nk(), (BATCH, 1), 0, 1024)
    positions = (offsets + jnp.arange(SEQ)[None, :]).astype(jnp.int32)
    return {
        "x": x,
        "positions": positions,
        "ffn1_w_gate": normal((Ld, D_MODEL, D_FF), D_MODEL ** -0.5),
        "ffn1_w_up": normal((Ld, D_MODEL, D_FF), D_MODEL ** -0.5),
        "ffn1_w_down": normal((Ld, D_FF, D_MODEL), BETA * D_FF ** -0.5),
        "ln1_g": 1.0 + normal((Ld, D_MODEL), 0.02),
        "ln1_b": normal((Ld, D_MODEL), 0.02),
        "w_in": normal((Ld, D_MODEL, PROJ_DIM), D_MODEL ** -0.5),
        "mu_r": unif((Ld, RWKV_DIM), 0.0, 1.0),
        "mu_k": unif((Ld, RWKV_DIM), 0.0, 1.0),
        "mu_v": unif((Ld, RWKV_DIM), 0.0, 1.0),
        "mu_w": unif((Ld, DECAY_LORA), 0.0, 1.0),
        "mu_a": unif((Ld, ICLR_LORA), 0.0, 1.0),
        "mu_g": unif((Ld, GATE_LORA), 0.0, 1.0),
        "w0": unif((Ld, RWKV_DIM), -6.5, -1.5),
        "w2": normal((Ld, DECAY_LORA, RWKV_DIM), 0.5 * DECAY_LORA ** -0.5),
        "a0": normal((Ld, RWKV_DIM), 0.1),
        "a2": normal((Ld, ICLR_LORA, RWKV_DIM), ICLR_LORA ** -0.5),
        "g2": normal((Ld, GATE_LORA, RWKV_DIM), GATE_LORA ** -0.5),
        "k_k": 0.85 + normal((Ld, RWKV_DIM), 0.05),
        "k_a": 1.0 + normal((Ld, RWKV_DIM), 0.05),
        "r_k": normal((Ld, RWKV_HEADS, HEAD_DIM), 0.1),
        "gn_g": 1.0 + normal((Ld, RWKV_DIM), 0.02),
        "gn_b": normal((Ld, RWKV_DIM), 0.02),
        "w_out": normal((Ld, D_MODEL, D_MODEL), BETA * D_MODEL ** -0.5),
        "ln2_g": 1.0 + normal((Ld, D_MODEL), 0.02),
        "ln2_b": normal((Ld, D_MODEL), 0.02),
        "ffn2_w_gate": normal((Ld, D_MODEL, D_FF), D_MODEL ** -0.5),
        "ffn2_w_up": normal((Ld, D_MODEL, D_FF), D_MODEL ** -0.5),
        "ffn2_w_down": normal((Ld, D_FF, D_MODEL), BETA * D_FF ** -0.5),
        "ln3_g": 1.0 + normal((Ld, D_MODEL), 0.02),
        "ln3_b": normal((Ld, D_MODEL), 0.02),
    }


def reference(x, positions, ffn1_w_gate, ffn1_w_up, ffn1_w_down, ln1_g, ln1_b, w_in,
              mu_r, mu_k, mu_v, mu_w, mu_a, mu_g, w0, w2, a0, a2, g2, k_k, k_a, r_k,
              gn_g, gn_b, w_out, ln2_g, ln2_b, ffn2_w_gate, ffn2_w_up, ffn2_w_down, ln3_g, ln3_b):
    h = x
    for l in range(DEPTH):
        h = _layer_norm(ALPHA * h + 0.5 * _swiglu(h, ffn1_w_gate[l], ffn1_w_up[l], ffn1_w_down[l]),
                        ln1_g[l], ln1_b[l])
        mix = _hybrid_mixer(h, positions, w_in[l], mu_r[l], mu_k[l], mu_v[l], mu_w[l], mu_a[l], mu_g[l],
                            w0[l], w2[l], a0[l], a2[l], g2[l], k_k[l], k_a[l], r_k[l],
                            gn_g[l], gn_b[l], w_out[l])
        h = _layer_norm(ALPHA * h + mix, ln2_g[l], ln2_b[l])
        h = _layer_norm(ALPHA * h + 0.5 * _swiglu(h, ffn2_w_gate[l], ffn2_w_up[l], ffn2_w_down[l]),
                        ln3_g[l], ln3_b[l])
    return h
```

```cpp
#include <hip/hip_runtime.h>
#include <hip/hip_cooperative_groups.h>
#include <cstdio>
namespace cg = cooperative_groups;

#ifndef N_LAUNCH_MODE
#define N_LAUNCH_MODE 1
#endif

#define LAS __attribute__((address_space(3)))
typedef unsigned short bf16_t;
typedef short bf16x8 __attribute__((ext_vector_type(8)));
typedef float f32x4 __attribute__((ext_vector_type(4)));
typedef float f32x2 __attribute__((ext_vector_type(2)));
typedef unsigned u32x4 __attribute__((ext_vector_type(4)));
typedef unsigned u32x2 __attribute__((ext_vector_type(2)));

constexpr int T_ = 8192, B_ = 2, M_ = B_ * T_, D_ = 2048, FF_ = 5632;
constexpr int RW_ = 1280, NHR_ = 20, NHA_ = 12, AD_ = 768;
constexpr int NIN_ = 6656;
constexpr float ALPHA_ = 1.189207115002721f;
constexpr float LN_EPS_ = 1e-5f, GN_EPS_ = 64e-5f;
constexpr int NPHASE = 15;
constexpr int LDS_BYTES = 131072;

constexpr size_t MiB = 1048576ull;
constexpr size_t WS_HF = 0;
constexpr size_t WS_WIN = 128 * MiB;
constexpr size_t WS_WOUT = 154 * MiB;
constexpr size_t WS_WLORA = 290 * MiB + 262144;
constexpr size_t WS_WGU = 164 * MiB;
constexpr size_t WS_WD = 208 * MiB;
constexpr size_t WS_XB = 230 * MiB;
constexpr size_t WS_H = 294 * MiB;
constexpr size_t WS_PRKV = 294 * MiB;
constexpr size_t WS_PLORA = 438 * MiB;
constexpr size_t WS_PV = 470 * MiB;
constexpr size_t WS_XLORA = 414 * MiB;
constexpr size_t WS_LW = 164 * MiB;
constexpr size_t WS_LA = 204 * MiB;
constexpr size_t WS_LG = 164 * MiB;
constexpr size_t WS_Y = 248 * MiB;
constexpr size_t WS_LSE = 288 * MiB;
constexpr size_t WS_O = 438 * MiB;
constexpr size_t WS_Z2 = 294 * MiB;
constexpr size_t DO_PQ = 0, DO_PK = 24 * MiB, DO_VT = 48 * MiB, DO_YY = 0;

struct Params {
    const float* in[32];
    float* out;
    unsigned char* ws;
    int ph_lo, ph_hi;
};

__device__ __forceinline__ bf16_t f2bf(float f) { unsigned u = __float_as_uint(f); u += 0x7FFFu + ((u >> 16) & 1u); return (bf16_t)(u >> 16); }
__device__ __forceinline__ float bf2f(bf16_t b) { return __uint_as_float(((unsigned)b) << 16); }
__device__ __forceinline__ unsigned cvt_pk_bf16(float lo, float hi) { unsigned r; asm("v_cvt_pk_bf16_f32 %0, %1, %2" : "=v"(r) : "v"(lo), "v"(hi)); return r; }
__device__ __forceinline__ float bflo(unsigned w) { return __uint_as_float(w << 16); }
__device__ __forceinline__ float bfhi(unsigned w) { return __uint_as_float(w & 0xffff0000u); }
template <int CTRL> __device__ __forceinline__ float dppf(float x) { return __builtin_bit_cast(float, __builtin_amdgcn_update_dpp(0, __builtin_bit_cast(int, x), CTRL, 0xf, 0xf, false)); }
__device__ __forceinline__ int tidx() { int t = threadIdx.x; asm volatile("" : "+v"(t)); return t; }
__device__ __forceinline__ float red16(float x) {
    x += dppf<0xB1>(x); x += dppf<0x4E>(x); x += dppf<0x141>(x); x += dppf<0x128>(x); return x;
}
__device__ __forceinline__ float wave_sum(float x) {
#pragma unroll
    for (int o = 32; o >= 1; o >>= 1) x += __shfl_xor(x, o);
    return x;
}

namespace pg8 {
constexpr int BM = 256, BK = 64, HALF = 128, HTB = HALF * BK * 2, STAGE_BYTES = 8 * HTB, NXCD = 8, WGM = 8;
__device__ __forceinline__ int lds_byte(int r, int c) { const int st = (r >> 4) * 2 + (c >> 5), rr = r & 15, cc = c & 31, ob = rr * 64 + cc * 2; return st * 1024 + (ob ^ (((ob >> 9) & 1) << 5)); }
__device__ __forceinline__ void stage_rc(int b, int& R, int& C) { const int st = b / 1024, sb = b % 1024, swz = sb ^ (((sb >> 9) & 1) << 5); R = (st >> 1) * 16 + swz / 64; C = (st & 1) * 32 + (swz % 64) / 2; }
__device__ __forceinline__ int perm32(int rho) { const int n = rho >> 4, i = rho & 15; return 8 * (i >> 2) + 4 * n + (i & 3); }
struct Unit { int pm, pn; };
struct Gemm { const bf16_t* A; const bf16_t* Bt; int M, N, K, lda, ldb; };
struct StaticOrder {
    int nM, nN, nwg, G, c;
    __device__ void init(int M, int N, int G_, int c_) { nM = M / BM; nN = N / BM; nwg = nM * nN; G = G_; c = c_; }
    __device__ bool next(int i, Unit& u) const {
        const long L = (long)i * G + c; if (L >= nwg) return false;
        int wgid = (int)L; { const int q = nwg / NXCD, r = nwg % NXCD, xcd = wgid % NXCD, off = wgid / NXCD; wgid = (xcd < r ? xcd * (q + 1) : r * (q + 1) + (xcd - r) * q) + off; }
        const int nig = WGM * nN, gid = wgid / nig, fm = gid * WGM, gsz = (nM - fm) < WGM ? (nM - fm) : WGM;
        u.pm = fm + ((wgid % nig) % gsz); u.pn = (wgid % nig) / gsz; return true;
    }
};

template <class Epi>
__device__ __forceinline__ void gemm_phase(LAS unsigned char* lds, const Gemm g, const StaticOrder& S, const Epi& E) {
    const int tid = tidx(), wid = __builtin_amdgcn_readfirstlane(tid >> 6), lane = tid & 63, wr = wid >> 2, wc = wid & 3, fr = lane & 15, fq = lane >> 4;
    int K = g.K, lda_ = g.lda, ldb_ = g.ldb; asm volatile("" : "+s"(K), "+s"(lda_), "+s"(ldb_));
    const int nt = K / BK;
    unsigned voffA[2], voffB[2];
#pragma unroll
    for (int i = 0; i < 2; ++i) { int R, C; stage_rc(tid * 16 + i * 8192, R, C); const int Rb = Epi::PERM ? ((R & ~31) + perm32(R & 31)) : R;
        voffA[i] = (unsigned)(R * lda_ + C) * 2u; voffB[i] = (unsigned)(Rb * ldb_ + C) * 2u; }
    const size_t kstep = (size_t)(BK * 2);
    const size_t hstepA = (size_t)HALF * lda_ * 2, hstepB = (size_t)HALF * ldb_ * 2;
    const size_t tstepA = 2 * hstepA, tstepB = 2 * hstepB;
    const unsigned ldsw = (unsigned)wid * 1024u;
    const int aoff = lds_byte(wr * 64 + fr, fq * 8), boff = lds_byte(wc * 32 + fr, fq * 8);
#define PG8_SA(b, h) (((b) * 2 + (h)) * HTB)
#define PG8_SB(b, h) ((4 + (b) * 2 + (h)) * HTB)
#define PG8_STAGE(bufoff, gbase, voff) do { _Pragma("unroll") for (int _i = 0; _i < 2; ++_i) \
        __builtin_amdgcn_global_load_lds((const unsigned*)((const char*)(gbase) + (voff)[_i]), (LAS unsigned*)(lds + (bufoff) + ldsw + _i * 8192), 16, 0, 0); } while (0)
#define PG8_LDA(dst, b, h) do { _Pragma("unroll") for (int m = 0; m < 4; ++m) _Pragma("unroll") for (int k = 0; k < 2; ++k) dst[m][k] = *(const LAS bf16x8*)(lds + PG8_SA(b, h) + aoff + m * 2048 + k * 1024); } while (0)
#define PG8_LDB(dst, b, h) do { _Pragma("unroll") for (int n = 0; n < 2; ++n) _Pragma("unroll") for (int k = 0; k < 2; ++k) dst[n][k] = *(const LAS bf16x8*)(lds + PG8_SB(b, h) + boff + n * 2048 + k * 1024); } while (0)
#define PG8_MMA(ai, bj, At, Bt) do { __builtin_amdgcn_s_setprio(1); _Pragma("unroll") for (int m = 0; m < 4; ++m) _Pragma("unroll") for (int n = 0; n < 2; ++n) _Pragma("unroll") for (int k = 0; k < 2; ++k) \
        acc[ai][bj][m][n] = __builtin_amdgcn_mfma_f32_16x16x32_bf16(Bt[n][k], At[m][k], acc[ai][bj][m][n], 0, 0, 0); __builtin_amdgcn_s_setprio(0); } while (0)
#define PG8_WAIT_V(n) asm volatile("s_waitcnt vmcnt(" #n ")" ::: "memory")
#define PG8_WAIT_L(n) asm volatile("s_waitcnt lgkmcnt(" #n ")" ::: "memory")
#define PG8_BAR __builtin_amdgcn_s_barrier()
#define PG8_SCHED __builtin_amdgcn_sched_barrier(0)
    Unit cur, nxt; int ui = 0;
    if (!S.next(0, cur)) return;
    f32x4 acc[2][2][4][2];
#pragma unroll
    for (int a = 0; a < 2; ++a)
#pragma unroll
        for (int b = 0; b < 2; ++b)
#pragma unroll
            for (int m = 0; m < 4; ++m)
#pragma unroll
                for (int n = 0; n < 2; ++n) acc[a][b][m][n] = (f32x4){0.f, 0.f, 0.f, 0.f};
    bf16x8 At[4][2], B0[2][2], B1[2][2];
    const char* cA = (const char*)g.A + (size_t)cur.pm * tstepA; const char* cB = (const char*)g.Bt + (size_t)cur.pn * tstepB;
    PG8_STAGE(PG8_SB(0, 0), cB, voffB); PG8_STAGE(PG8_SA(0, 0), cA, voffA); PG8_STAGE(PG8_SB(0, 1), cB + hstepB, voffB); PG8_STAGE(PG8_SA(0, 1), cA + hstepA, voffA);
    if (wr == 1) PG8_BAR;
    PG8_WAIT_V(4); PG8_BAR;
    PG8_STAGE(PG8_SB(1, 0), cB + kstep, voffB); PG8_STAGE(PG8_SA(1, 0), cA + kstep, voffA); PG8_STAGE(PG8_SB(1, 1), cB + hstepB + kstep, voffB);
    PG8_WAIT_V(6); PG8_BAR;
    for (;;) {
        const bool has_next = S.next(ui + 1, nxt);
        const char* nA = has_next ? (const char*)g.A + (size_t)nxt.pm * tstepA : cA; const char* nB = has_next ? (const char*)g.Bt + (size_t)nxt.pn * tstepB : cB;
        for (int t = 0; t < nt; t += 2) {
            const bool last = (t == nt - 2);
            const char* a1 = cA + (size_t)(t + 1) * kstep;
            const char* a2 = last ? nA : cA + (size_t)(t + 2) * kstep; const char* b2 = last ? nB : cB + (size_t)(t + 2) * kstep;
            const char* a3 = a2 + kstep; const char* b3 = b2 + kstep;
            PG8_LDB(B0, 0, 0); PG8_SCHED; PG8_LDA(At, 0, 0); PG8_STAGE(PG8_SA(1, 1), a1 + hstepA, voffA);
            PG8_WAIT_L(8); PG8_BAR; PG8_WAIT_L(0); PG8_MMA(0, 0, At, B0); PG8_BAR; PG8_SCHED;
            PG8_LDB(B1, 0, 1); PG8_STAGE(PG8_SB(0, 0), b2, voffB);
            PG8_BAR; PG8_WAIT_L(0); PG8_MMA(0, 1, At, B1); PG8_BAR;
            PG8_LDA(At, 0, 1); PG8_STAGE(PG8_SA(0, 0), a2, voffA);
            PG8_BAR; PG8_WAIT_L(0); PG8_MMA(1, 0, At, B0); PG8_BAR; PG8_SCHED;
            PG8_STAGE(PG8_SB(0, 1), b2 + hstepB, voffB);
            PG8_WAIT_V(6); PG8_BAR; PG8_MMA(1, 1, At, B1); PG8_BAR;
            PG8_LDB(B0, 1, 0); PG8_SCHED; PG8_LDA(At, 1, 0); PG8_STAGE(PG8_SA(0, 1), a2 + hstepA, voffA);
            PG8_WAIT_L(8); PG8_BAR; PG8_WAIT_L(0); PG8_MMA(0, 0, At, B0); PG8_BAR; PG8_SCHED;
            PG8_LDB(B1, 1, 1); PG8_STAGE(PG8_SB(1, 0), b3, voffB);
            PG8_BAR; PG8_WAIT_L(0); PG8_MMA(0, 1, At, B1); PG8_BAR;
            PG8_LDA(At, 1, 1); PG8_STAGE(PG8_SA(1, 0), a3, voffA);
            PG8_BAR; PG8_WAIT_L(0); PG8_MMA(1, 0, At, B0); PG8_BAR; PG8_SCHED;
            PG8_STAGE(PG8_SB(1, 1), b3 + hstepB, voffB);
            PG8_WAIT_V(6); PG8_BAR; PG8_MMA(1, 1, At, B1); PG8_BAR;
        }
        E(acc, cur, wr, wc, fr, fq);
        if (!has_next) break;
#pragma unroll
        for (int a = 0; a < 2; ++a)
#pragma unroll
            for (int b = 0; b < 2; ++b)
#pragma unroll
                for (int m = 0; m < 4; ++m)
#pragma unroll
                    for (int n = 0; n < 2; ++n) acc[a][b][m][n] = (f32x4){0.f, 0.f, 0.f, 0.f};
        cur = nxt; cA = nA; cB = nB; ++ui;
    }
    PG8_WAIT_V(0);
    if (wr == 0) PG8_BAR;
    PG8_BAR;
#undef PG8_SA
#undef PG8_SB
#undef PG8_STAGE
#undef PG8_LDA
#undef PG8_LDB
#undef PG8_MMA
#undef PG8_WAIT_V
#undef PG8_WAIT_L
#undef PG8_BAR
#undef PG8_SCHED
}
}

typedef f32x4 AccT[2][2][4][2];

__device__ __forceinline__ float silu_f(float x) { return x * __builtin_amdgcn_rcpf(1.0f + __expf(-x)); }

struct EpiSwiGLU {
    static constexpr bool PERM = true;
    bf16_t* H; int ldc;
    __device__ __forceinline__ void operator()(const AccT& acc, const pg8::Unit& u, int wr, int wc, int fr, int fq) const {
        asm volatile("" : "+v"(fr), "+v"(fq));
        const int row0 = u.pm * 256 + wr * 64 + fr, col0 = u.pn * 128 + wc * 32 + 8 * fq;
#pragma unroll
        for (int ai = 0; ai < 2; ++ai)
#pragma unroll
            for (int m = 0; m < 4; ++m) {
                bf16_t* rowp = H + (size_t)(row0 + ai * 128 + m * 16) * ldc + col0;
                const f32x4 g0 = acc[ai][0][m][0], g1 = acc[ai][0][m][1], u0 = acc[ai][1][m][0], u1 = acc[ai][1][m][1];
                u32x4 w;
                w.x = cvt_pk_bf16(silu_f(g0[0]) * u0[0], silu_f(g0[1]) * u0[1]); w.y = cvt_pk_bf16(silu_f(g0[2]) * u0[2], silu_f(g0[3]) * u0[3]);
                w.z = cvt_pk_bf16(silu_f(g1[0]) * u1[0], silu_f(g1[1]) * u1[1]); w.w = cvt_pk_bf16(silu_f(g1[2]) * u1[2], silu_f(g1[3]) * u1[3]);
                *(u32x4*)rowp = w;
            }
    }
};
struct EpiRes {
    static constexpr bool PERM = false;
    float* Z; const float* res; int ldc; float alpha, scale;
    __device__ __forceinline__ void operator()(const AccT& acc, const pg8::Unit& u, int wr, int wc, int fr, int fq) const {
        asm volatile("" : "+v"(fr), "+v"(fq));
        const int row0 = u.pm * 256 + wr * 64 + fr, col0 = u.pn * 256 + wc * 32 + 4 * fq;
#pragma unroll
        for (int ai = 0; ai < 2; ++ai)
#pragma unroll
            for (int m = 0; m < 4; ++m) {
                const size_t off = (size_t)(row0 + ai * 128 + m * 16) * ldc + col0;
#pragma unroll
                for (int bj = 0; bj < 2; ++bj)
#pragma unroll
                    for (int n = 0; n < 2; ++n) {
                        const f32x4 r = *(const f32x4*)(res + off + bj * 128 + n * 16);
                        *(f32x4*)(Z + off + bj * 128 + n * 16) = r * alpha + acc[ai][bj][m][n] * scale;
                    }
            }
    }
};
struct EpiWin {
    static constexpr bool PERM = true;
    unsigned char* ws; long delta;
    __device__ __forceinline__ void operator()(const AccT& acc, const pg8::Unit& u, int wr, int wc, int fr, int fq) const {
        asm volatile("" : "+v"(fr), "+v"(fq));
        const int row0 = u.pm * 256 + wr * 64 + fr, cl = wc * 32 + 8 * fq;
        if (u.pn == 15 || u.pn == 16) {
            const int colt = (u.pn - 15) * 256 + cl;
            float* Plora = (float*)(ws + WS_PLORA);
#pragma unroll
            for (int ai = 0; ai < 2; ++ai)
#pragma unroll
                for (int m = 0; m < 4; ++m) {
                    float* rowp = Plora + (size_t)(row0 + ai * 128 + m * 16) * 512 + colt;
#pragma unroll
                    for (int bj = 0; bj < 2; ++bj)
#pragma unroll
                        for (int n = 0; n < 2; ++n) *(f32x4*)(rowp + bj * 128 + n * 4) = acc[ai][bj][m][n];
                }
        } else {
            size_t boff; int ldc, colt; bool inws = true;
            if (u.pn < 15) { boff = WS_PRKV; ldc = 3840; colt = u.pn * 256; }
            else { const int t = (u.pn - 17) / 3; inws = (t == 2); boff = (t == 0) ? DO_PQ : (t == 1 ? DO_PK : WS_PV); ldc = 768; colt = ((u.pn - 17) % 3) * 256; }
            bf16_t* base = (bf16_t*)(ws + (long)boff + (inws ? 0l : delta));
#pragma unroll
            for (int ai = 0; ai < 2; ++ai)
#pragma unroll
                for (int m = 0; m < 4; ++m) {
                    bf16_t* rowp = base + (size_t)(row0 + ai * 128 + m * 16) * ldc + colt + cl;
#pragma unroll
                    for (int bj = 0; bj < 2; ++bj) {
                        const f32x4 v0 = acc[ai][bj][m][0], v1 = acc[ai][bj][m][1];
                        u32x4 w; w.x = cvt_pk_bf16(v0[0], v0[1]); w.y = cvt_pk_bf16(v0[2], v0[3]); w.z = cvt_pk_bf16(v1[0], v1[1]); w.w = cvt_pk_bf16(v1[2], v1[3]);
                        *(u32x4*)(rowp + bj * 128) = w;
                    }
                }
        }
    }
};
__device__ __forceinline__ int map_row(int n, int mode) {
    if (mode == 1) return (n >> 7) * 256 + (n & 127);
    if (mode == 2) return (n >> 7) * 256 + 128 + (n & 127);
    if (mode == 3) return n < 4288 ? n : n + 64;
    return n;
}
__device__ void convert_weight(const float* __restrict__ W, int K, int N, bf16_t* __restrict__ Wt, int ldk, int mode, float* tile, int bid, int G) {
    const int tid = tidx(), c = tid & 63, r0 = tid >> 6;
    const int tn_n = N / 64, tn_k = K / 64, ntile = tn_n * tn_k;
    for (int t = bid; t < ntile; t += G) {
        const int tk = t / tn_n, tn = t % tn_n;
#pragma unroll
        for (int i = 0; i < 8; ++i) { const int r = r0 + 8 * i; tile[r * 65 + c] = W[(size_t)(tk * 64 + r) * N + tn * 64 + c]; }
        __syncthreads();
        const int drow0 = map_row(tn * 64, mode);
#pragma unroll
        for (int i = 0; i < 8; ++i) { const int nl = r0 + 8 * i; Wt[(size_t)(drow0 + nl) * ldk + tk * 64 + c] = f2bf(tile[c * 65 + nl]); }
        __syncthreads();
    }
}
__device__ void convert_ffn_weights(const Params& p, int ig, int iu, int idn, float* tile, int bid, int G) {
    bf16_t* Wgu = (bf16_t*)(p.ws + WS_WGU); bf16_t* Wd = (bf16_t*)(p.ws + WS_WD);
    convert_weight(p.in[ig], D_, FF_, Wgu, D_, 1, tile, bid, G);
    convert_weight(p.in[iu], D_, FF_, Wgu, D_, 2, tile, (bid + 85) % G, G);
    convert_weight(p.in[idn], FF_, D_, Wd, FF_, 0, tile, (bid + 170) % G, G);
}

__device__ void ln_phase(const float* __restrict__ Z, const float* __restrict__ gam, const float* __restrict__ bet, float* outf, bf16_t* outb, int bid, int G) {
    const int tid = tidx(), wave = tid >> 6, lane = tid & 63;
    f32x4 gv[8], bv[8];
#pragma unroll
    for (int i = 0; i < 8; ++i) { gv[i] = *(const f32x4*)(gam + i * 256 + lane * 4); bv[i] = *(const f32x4*)(bet + i * 256 + lane * 4); }
    for (int row = bid * 8 + wave; row < M_; row += G * 8) {
        const float* zr = Z + (size_t)row * D_;
        f32x4 x[8]; float s = 0.f;
#pragma unroll
        for (int i = 0; i < 8; ++i) { x[i] = *(const f32x4*)(zr + i * 256 + lane * 4); s += (x[i][0] + x[i][1]) + (x[i][2] + x[i][3]); }
        s = wave_sum(s); const float mean = s * (1.0f / D_);
        float q = 0.f;
#pragma unroll
        for (int i = 0; i < 8; ++i) { x[i] = x[i] - mean; q += (x[i][0] * x[i][0] + x[i][1] * x[i][1]) + (x[i][2] * x[i][2] + x[i][3] * x[i][3]); }
        q = wave_sum(q); const float rstd = 1.0f / sqrtf(q * (1.0f / D_) + LN_EPS_);
#pragma unroll
        for (int i = 0; i < 8; ++i) {
            const f32x4 o = x[i] * rstd * gv[i] + bv[i];
            if (outf) *(f32x4*)(outf + (size_t)row * D_ + i * 256 + lane * 4) = o;
            if (outb) { u32x2 w; w.x = cvt_pk_bf16(o[0], o[1]); w.y = cvt_pk_bf16(o[2], o[3]); *(u32x2*)(outb + (size_t)row * D_ + i * 256 + lane * 4) = w; }
        }
    }
}

__device__ void phase_convert0(const Params& p, unsigned char* lds, int bid, int G) {
    float* tile = (float*)lds;
    const int tid = tidx();
    convert_ffn_weights(p, 2, 3, 4, tile, bid, G);
    convert_weight(p.in[7], D_, 6592, (bf16_t*)(p.ws + WS_WIN), D_, 3, tile, bid, G);
    convert_weight(p.in[24], D_, D_, (bf16_t*)(p.ws + WS_WOUT), D_, 0, tile, (bid + 128) % G, G);
    { unsigned* z = (unsigned*)((bf16_t*)(p.ws + WS_WIN) + (size_t)4288 * D_); for (int i = bid * 512 + tid; i < 64 * D_ / 2; i += G * 512) z[i] = 0u; }
    { const f32x4* x4 = (const f32x4*)p.in[0]; u32x2* o = (u32x2*)(p.ws + WS_XB);
      for (int i = bid * 512 + tid; i < M_ * D_ / 4; i += G * 512) { const f32x4 v = x4[i]; u32x2 w; w.x = cvt_pk_bf16(v[0], v[1]); w.y = cvt_pk_bf16(v[2], v[3]); o[i] = w; } }
}

__device__ void phase_prep(const Params& p, unsigned char* lds, int bid, int G) {
    const int tid = tidx();
    {
        bf16_t* WL = (bf16_t*)(p.ws + WS_WLORA);
        const float* s0 = p.in[15]; const float* s1 = p.in[17]; const float* s2 = p.in[18];
        for (int i = bid * 512 + tid; i < 1280 * 256; i += G * 512) {
            const int n = i >> 8, k = i & 255;
            WL[i] = (k < 96) ? f2bf(s0[(size_t)k * 1280 + n]) : (bf16_t)0;
            WL[1280 * 256 + i] = (k < 96) ? f2bf(s1[(size_t)k * 1280 + n]) : (bf16_t)0;
            WL[2 * 1280 * 256 + i] = f2bf(s2[(size_t)k * 1280 + n]);
        }
    }
    {
        const float* PL = (const float*)(p.ws + WS_PLORA); bf16_t* XL = (bf16_t*)(p.ws + WS_XLORA);
        const float* mu_w = p.in[11]; const float* mu_a = p.in[12]; const float* mu_g = p.in[13];
        for (int i = bid * 512 + tid; i < M_ * 768; i += G * 512) {
            const int t = i / 768, c = i % 768; float o = 0.f;
            int src = -1; float mu = 0.f; int kind = 0;
            if (c < 96) { src = c; mu = mu_w[c]; kind = 0; }
            else if (c >= 256 && c < 352) { src = 96 + (c - 256); mu = mu_a[c - 256]; kind = 1; }
            else if (c >= 512) { src = 192 + (c - 512); mu = mu_g[c - 512]; kind = 2; }
            if (src >= 0) {
                const float z = PL[(size_t)t * 512 + src]; const float zp = (t % T_) ? PL[(size_t)(t - 1) * 512 + src] : 0.f;
                const float s = z + (zp - z) * mu;
                o = (kind == 0) ? tanhf(s) : (kind == 1 ? s : 1.0f / (1.0f + expf(-s)));
            }
            XL[i] = f2bf(o);
        }
    }
    {
        bf16_t* Pq = (bf16_t*)((unsigned char*)p.out + DO_PQ); bf16_t* Pk = (bf16_t*)((unsigned char*)p.out + DO_PK);
        const int* pos = (const int*)p.in[1];
        for (int i = bid * 512 + tid; i < M_ * 2 * NHA_ * 8; i += G * 512) {
            const int j = i & 7, hh = (i >> 3) % NHA_, qk = (i / (8 * NHA_)) & 1, t = i / (16 * NHA_);
            bf16_t* P = (qk ? Pk : Pq) + (size_t)t * AD_ + hh * 64;
            const float invf = (float)pow(500000.0, -(double)j / 8.0);
            const float ang = (float)pos[t] * invf; const double rv = (double)ang * 0.15915494309189535; const float rev = (float)(rv - rint(rv));
            const float sn = __builtin_amdgcn_sinf(rev), cs = __builtin_amdgcn_cosf(rev);
            const float x1 = bf2f(P[j]), x2 = bf2f(P[8 + j]);
            P[j] = f2bf(x1 * cs - x2 * sn); P[8 + j] = f2bf(x2 * cs + x1 * sn);
        }
    }
    {
        const bf16_t* Pv = (const bf16_t*)(p.ws + WS_PV); bf16_t* VT = (bf16_t*)((unsigned char*)p.out + DO_VT);
        bf16_t* tl = (bf16_t*)lds;
        for (int job = bid; job < (M_ / 256) * NHA_; job += G) {
            const int hh = job % NHA_, tb = job / NHA_, tok0 = tb * 256, b = tok0 / T_, t0 = tok0 % T_;
            __syncthreads();
            for (int i = tid; i < 256 * 32; i += 512) { const int tr = i >> 5, cp = i & 31; *(unsigned*)(tl + tr * 66 + cp * 2) = *(const unsigned*)(Pv + (size_t)(tok0 + tr) * AD_ + hh * 64 + cp * 2); }
            __syncthreads();
#pragma unroll
            for (int g = 0; g < 3; ++g) {
                const int sh = 2 * g, d = 1 << sh, per = 256 >> sh;
                bf16_t* dst = VT + (size_t)g * M_ * AD_ + ((size_t)(b * NHA_ + hh) * 64) * T_;
                for (int o = tid; o < 64 * 256; o += 512) {
                    const int e = o >> 8, j = o & 255, r = j / per, q = j % per, tloc = q * d + r;
                    dst[(size_t)e * T_ + r * (T_ >> sh) + (t0 >> sh) + q] = tl[tloc * 66 + e];
                }
            }
        }
        __syncthreads();
    }
}

__device__ __forceinline__ float lora_act(int which, float x, float c) {
    if (which == 0) { const float z = -(c + x); const float sp = fmaxf(z, 0.f) + __logf(1.0f + __expf(-fabsf(z))); return __expf(-sp - 0.5f); }
    if (which == 1) return __builtin_amdgcn_rcpf(1.0f + __expf(-(c + x)));
    return x;
}
__device__ void lora_phase(const Params& p, unsigned char* lds, int wlo, int whi, int bid, int G) {
    const int tid = tidx(), wave = tid >> 6, lane = tid & 63, rl = lane & 15, gq = lane >> 4;
    const bf16_t* XL = (const bf16_t*)(p.ws + WS_XLORA); const bf16_t* WL = (const bf16_t*)(p.ws + WS_WLORA);
    unsigned char* Ash = lds;
    unsigned char* Bsh = lds + 128 * 528;
    asm volatile("" : "+s"(wlo), "+s"(whi));
    const int nw = whi - wlo, nitem = 128 * nw * 2;
    for (int item = bid; item < nitem; item += G) {
        const int half = item & 1, which = wlo + (item >> 1) % nw, rb = (item >> 1) / nw;
        const int K = (which == 2) ? 256 : 128, koff = which * 256, cpr = K / 8;
        bf16_t* Ob = (bf16_t*)(p.ws + (which == 0 ? WS_LW : (which == 1 ? WS_LA : WS_LG)));
        const float* cvec = (which == 0) ? p.in[14] : p.in[16];
        __syncthreads();
        for (int c = tid; c < 128 * cpr; c += 512) { const int r = c / cpr, ck = c % cpr; *(u32x4*)(Ash + r * 528 + ck * 16) = *(const u32x4*)(XL + (size_t)(rb * 128 + r) * 768 + koff + ck * 8); }
        for (int cb = 0; cb < 10; ++cb) {
            const int col0 = (half * 10 + cb) * 64;
            __syncthreads();
            for (int c = tid; c < 64 * cpr; c += 512) { const int r = c / cpr, ck = c % cpr; *(u32x4*)(Bsh + r * 528 + ck * 16) = *(const u32x4*)(WL + (size_t)which * 1280 * 256 + (size_t)(col0 + r) * 256 + ck * 8); }
            __syncthreads();
            f32x4 acc[4];
#pragma unroll
            for (int nt = 0; nt < 4; ++nt) acc[nt] = (f32x4){0.f, 0.f, 0.f, 0.f};
            for (int ks = 0; ks < K / 32; ++ks) {
                const bf16x8 Af = *(const bf16x8*)(Ash + (16 * wave + rl) * 528 + ks * 64 + gq * 16);
#pragma unroll
                for (int nt = 0; nt < 4; ++nt) { const bf16x8 Bf = *(const bf16x8*)(Bsh + (16 * nt + rl) * 528 + ks * 64 + gq * 16); acc[nt] = __builtin_amdgcn_mfma_f32_16x16x32_bf16(Bf, Af, acc[nt], 0, 0, 0); }
            }
            const size_t row = (size_t)rb * 128 + 16 * wave + rl;
#pragma unroll
            for (int nt = 0; nt < 4; ++nt) {
                const int col = col0 + 16 * nt + 4 * gq; f32x4 cv = {0.f, 0.f, 0.f, 0.f};
                if (which != 2) cv = *(const f32x4*)(cvec + col);
                u32x2 w; w.x = cvt_pk_bf16(lora_act(which, acc[nt][0], cv[0]), lora_act(which, acc[nt][1], cv[1])); w.y = cvt_pk_bf16(lora_act(which, acc[nt][2], cv[2]), lora_act(which, acc[nt][3], cv[3]));
                *(u32x2*)(Ob + row * RW_ + col) = w;
            }
        }
    }
    __syncthreads();
}

__device__ void scan_unit(const Params& p, unsigned char* lds, int bh, int qd) {
    const int tid = tidx(), wave = tid >> 6, lane = tid & 63;
    const int b = bh / NHR_, h = bh % NHR_;
    float* bufX = (float*)lds;
    float* bufV = (float*)(lds + 81920);
    float* bufY = (float*)(lds + 81920 + 4096);
    const bf16_t* Prkv = (const bf16_t*)(p.ws + WS_PRKV); const bf16_t* Lw = (const bf16_t*)(p.ws + WS_LW); const bf16_t* La = (const bf16_t*)(p.ws + WS_LA);
    bf16_t* Y = (bf16_t*)(p.ws + WS_Y);
    const bool loader = wave >= 4;
    const int ts = lane >> 4, cg = lane & 15, ch = h * 64 + cg * 4;
    f32x4 mu_r = {0, 0, 0, 0}, mu_k = mu_r, mu_v = mu_r, k_k = mu_r, k_a = mu_r;
    if (loader) { mu_r = *(const f32x4*)(p.in[8] + ch); mu_k = *(const f32x4*)(p.in[9] + ch); mu_v = *(const f32x4*)(p.in[10] + ch); k_k = *(const f32x4*)(p.in[19] + ch); k_a = *(const f32x4*)(p.in[20] + ch); }
    const int lw = wave - 4;
    f32x4 S = {0.f, 0.f, 0.f, 0.f};
    const int rowl = 4 * (wave & 3) + (lane >> 4);

    auto fill = [&](int c, int buf) {
#pragma unroll
        for (int gi = 0; gi < 2; ++gi) {
            const int tl = 4 * (lw + 4 * gi) + ts, tseq = c * 32 + tl; const size_t tok = (size_t)b * T_ + tseq;
            const bf16_t* pr = Prkv + tok * 3840 + ch;
            const u32x2 rr = *(const u32x2*)pr, kr_ = *(const u32x2*)(pr + 1280), vr = *(const u32x2*)(pr + 2560);
            u32x2 rp = {0u, 0u}, kp = rp, vp = rp;
            if (tseq > 0) { rp = *(const u32x2*)(pr - 3840); kp = *(const u32x2*)(pr - 3840 + 1280); vp = *(const u32x2*)(pr - 3840 + 2560); }
            const u32x2 ew2 = *(const u32x2*)(Lw + tok * 1280 + ch), a2 = *(const u32x2*)(La + tok * 1280 + ch);
            const f32x4 r0 = {bflo(rr.x), bfhi(rr.x), bflo(rr.y), bfhi(rr.y)}, r1 = {bflo(rp.x), bfhi(rp.x), bflo(rp.y), bfhi(rp.y)};
            const f32x4 k0 = {bflo(kr_.x), bfhi(kr_.x), bflo(kr_.y), bfhi(kr_.y)}, k1 = {bflo(kp.x), bfhi(kp.x), bflo(kp.y), bfhi(kp.y)};
            const f32x4 v0 = {bflo(vr.x), bfhi(vr.x), bflo(vr.y), bfhi(vr.y)}, v1 = {bflo(vp.x), bfhi(vp.x), bflo(vp.y), bfhi(vp.y)};
            const f32x4 ew = {bflo(ew2.x), bfhi(ew2.x), bflo(ew2.y), bfhi(ew2.y)}, av = {bflo(a2.x), bfhi(a2.x), bflo(a2.y), bfhi(a2.y)};
            const f32x4 r = r0 + (r1 - r0) * mu_r, k = k0 + (k1 - k0) * mu_k, v = v0 + (v1 - v0) * mu_v;
            f32x4 dec;
#pragma unroll
            for (int j = 0; j < 4; ++j) dec[j] = __builtin_amdgcn_exp2f(ew[j] * -1.4426950408889634f);
            const f32x4 kku = k * k_k;
            float s1 = (kku[0] * kku[0] + kku[1] * kku[1]) + (kku[2] * kku[2] + kku[3] * kku[3]);
            s1 = red16(s1);
            const float rn = 1.0f / fmaxf(sqrtf(s1), 1e-12f);
            const f32x4 kk = kku * rn;
            const f32x4 k2 = k * (1.0f + (av - 1.0f) * k_a);
            float* X = bufX + ((size_t)(buf * 32 + tl)) * 320 + cg * 4;
            *(f32x4*)(X) = dec; *(f32x4*)(X + 64) = -kk; *(f32x4*)(X + 128) = kk * av; *(f32x4*)(X + 192) = k2; *(f32x4*)(X + 256) = r;
            if ((cg >> 2) == qd) *(f32x4*)(bufV + (buf * 32 + tl) * 16 + (cg & 3) * 4) = v;
        }
    };
    auto store_y = [&](int c, int buf) {
        const int lt = tid - 256, tl = lt >> 3, pr = lt & 7;
        const float y0 = bufY[(buf * 32 + tl) * 16 + 2 * pr], y1 = bufY[(buf * 32 + tl) * 16 + 2 * pr + 1];
        *(unsigned*)(Y + ((size_t)b * T_ + c * 32 + tl) * 1280 + h * 64 + 16 * qd + 2 * pr) = cvt_pk_bf16(y0, y1);
    };

    __syncthreads();
    if (loader) fill(0, 0);
    __syncthreads();
    for (int c = 0; c < T_ / 32; ++c) {
        const int buf = c & 1;
        if (!loader) {
#pragma unroll 8
            for (int t = 0; t < 32; ++t) {
                const float* X = bufX + (size_t)(buf * 32 + t) * 320 + cg * 4;
                const f32x4 w = *(const f32x4*)X, a = *(const f32x4*)(X + 64), bb = *(const f32x4*)(X + 128), k = *(const f32x4*)(X + 192), r = *(const f32x4*)(X + 256);
                const float v = bufV[(buf * 32 + t) * 16 + rowl];
                float sa = (S[0] * a[0] + S[1] * a[1]) + (S[2] * a[2] + S[3] * a[3]);
                sa = red16(sa);
                S = S * w + bb * sa + k * v;
                float y = (S[0] * r[0] + S[1] * r[1]) + (S[2] * r[2] + S[3] * r[3]);
                y = red16(y);
                if (cg == 0) bufY[(buf * 32 + t) * 16 + rowl] = y;
            }
        } else {
            if (c + 1 < T_ / 32) fill(c + 1, buf ^ 1);
            if (c > 0) store_y(c - 1, buf ^ 1);
        }
        __syncthreads();
    }
    if (loader) store_y(T_ / 32 - 1, 1);
    __syncthreads();
}

__device__ void attn_item(const Params& p, unsigned char* lds, int item) {
    const int tid = tidx(), wave = tid >> 6, lane = tid & 63, qn = lane & 15, gq = lane >> 4;
    const int g = item / 1536, rem = item % 1536, b = rem / 768, hh = (rem >> 6) % NHA_, rn = rem & 63;
    const int sh = 2 * g, d = 1 << sh, L = T_ >> sh, nb = 64 >> sh, r = rn / nb, n = rn % nb;
    const bf16_t* Pq = (const bf16_t*)((unsigned char*)p.out + DO_PQ); const bf16_t* Pk = (const bf16_t*)((unsigned char*)p.out + DO_PK);
    const bf16_t* VT = (const bf16_t*)((unsigned char*)p.out + DO_VT) + (size_t)g * M_ * AD_ + ((size_t)(b * NHA_ + hh) * 64) * T_;
    bf16_t* Og = (bf16_t*)(p.ws + WS_O) + (size_t)g * M_ * AD_; float* lse = (float*)(p.ws + WS_LSE) + (size_t)g * M_ * NHA_;
    unsigned char* Ksh = lds;
    unsigned char* Vsh = lds + 256 * 144;
    __syncthreads();
#pragma unroll
    for (int i = 0; i < 4; ++i) {
        const int chunk = tid + 512 * i, kap = chunk >> 3, part = chunk & 7;
        const int lp = 128 * (n - 1) + kap; u32x4 val = {0u, 0u, 0u, 0u};
        if (lp >= 0) val = *(const u32x4*)(Pk + ((size_t)b * T_ + (size_t)lp * d + r) * AD_ + hh * 64 + part * 8);
        const int row = (kap & 0xE0) | (((kap >> 2) & 1) << 4) | (((kap >> 3) & 3) << 2) | (kap & 3);
        *(u32x4*)(Ksh + row * 144 + part * 16) = val;
    }
#pragma unroll
    for (int i = 0; i < 4; ++i) {
        const int chunk = tid + 512 * i, e = chunk >> 5, part = chunk & 31, k0 = part * 8;
        u32x4 val = {0u, 0u, 0u, 0u};
        if (n > 0 || k0 >= 128) val = *(const u32x4*)(VT + (size_t)e * T_ + r * L + 128 * (n - 1) + k0);
        *(u32x4*)(Vsh + e * 528 + part * 16) = val;
    }
    const int q = 16 * wave + qn; const size_t qtok = (size_t)b * T_ + (size_t)(128 * n + q) * d + r;
    const bf16x8 Q0 = *(const bf16x8*)(Pq + qtok * AD_ + hh * 64 + gq * 8), Q1 = *(const bf16x8*)(Pq + qtok * AD_ + hh * 64 + 32 + gq * 8);
    __syncthreads();
    const int s0 = wave >> 1;
    f32x4 sacc[5][2];
#pragma unroll
    for (int st = 0; st < 5; ++st)
#pragma unroll
        for (int bb = 0; bb < 2; ++bb) {
            const int row = (s0 + st) * 32 + bb * 16 + qn;
            const bf16x8 K0 = *(const bf16x8*)(Ksh + row * 144 + gq * 16), K1 = *(const bf16x8*)(Ksh + row * 144 + 64 + gq * 16);
            f32x4 a = {0.f, 0.f, 0.f, 0.f};
            a = __builtin_amdgcn_mfma_f32_16x16x32_bf16(K0, Q0, a, 0, 0, 0);
            a = __builtin_amdgcn_mfma_f32_16x16x32_bf16(K1, Q1, a, 0, 0, 0);
            sacc[st][bb] = a;
        }
    const float SC = 0.125f * 1.4426950408889634f;
    float mx = -INFINITY;
#pragma unroll
    for (int st = 0; st < 5; ++st)
#pragma unroll
        for (int bb = 0; bb < 2; ++bb)
#pragma unroll
            for (int i = 0; i < 4; ++i) {
                const int kap = 32 * (s0 + st) + 8 * gq + 4 * bb + i, rel = q + 128 - kap;
                const bool valid = (rel >= 0) && (rel <= 128) && (n > 0 || kap >= 128);
                const float sv = valid ? sacc[st][bb][i] * SC : -INFINITY;
                sacc[st][bb][i] = sv; mx = fmaxf(mx, sv);
            }
    mx = fmaxf(mx, __shfl_xor(mx, 16)); mx = fmaxf(mx, __shfl_xor(mx, 32));
    float den = 0.f; bf16x8 Pf[5];
#pragma unroll
    for (int st = 0; st < 5; ++st) {
        float pv[8];
#pragma unroll
        for (int bb = 0; bb < 2; ++bb)
#pragma unroll
            for (int i = 0; i < 4; ++i) { const float pe = __builtin_amdgcn_exp2f(sacc[st][bb][i] - mx); pv[bb * 4 + i] = pe; den += pe; }
        u32x4 w; w.x = cvt_pk_bf16(pv[0], pv[1]); w.y = cvt_pk_bf16(pv[2], pv[3]); w.z = cvt_pk_bf16(pv[4], pv[5]); w.w = cvt_pk_bf16(pv[6], pv[7]);
        Pf[st] = __builtin_bit_cast(bf16x8, w);
    }
    den += __shfl_xor(den, 16); den += __shfl_xor(den, 32);
    f32x4 oacc[4];
#pragma unroll
    for (int et = 0; et < 4; ++et) oacc[et] = (f32x4){0.f, 0.f, 0.f, 0.f};
#pragma unroll
    for (int st = 0; st < 5; ++st)
#pragma unroll
        for (int et = 0; et < 4; ++et) {
            const bf16x8 Vf = *(const bf16x8*)(Vsh + (16 * et + qn) * 528 + ((s0 + st) * 32 + 8 * gq) * 2);
            oacc[et] = __builtin_amdgcn_mfma_f32_16x16x32_bf16(Vf, Pf[st], oacc[et], 0, 0, 0);
        }
    const float inv = 1.0f / den;
#pragma unroll
    for (int et = 0; et < 4; ++et) {
        u32x2 w; w.x = cvt_pk_bf16(oacc[et][0] * inv, oacc[et][1] * inv); w.y = cvt_pk_bf16(oacc[et][2] * inv, oacc[et][3] * inv);
        *(u32x2*)(Og + qtok * AD_ + hh * 64 + 16 * et + 4 * gq) = w;
    }
    if (gq == 0) lse[qtok * NHA_ + hh] = mx * 0.6931471805599453f + logf(den);
}

__device__ void phase_scan_attn(const Params& p, unsigned char* lds, int bid, int G) {
    constexpr int NSCAN = 160, NITEM = 3 * 1536;
    if (G > NSCAN) {
        if (bid < NSCAN) { const int xcd = bid & 7, slot = bid >> 3; scan_unit(p, lds, xcd * 5 + (slot >> 2), slot & 3); }
        else { for (int it = bid - NSCAN; it < NITEM; it += G - NSCAN) attn_item(p, lds, it); }
    } else {
        for (int u = bid; u < NSCAN; u += G) scan_unit(p, lds, u >> 2, u & 3);
        for (int it = bid; it < NITEM; it += G) attn_item(p, lds, it);
    }
    __syncthreads();
}

__device__ void phase_post(const Params& p, int bid, int G) {
    const int tid = tidx(), wave = tid >> 6, lane = tid & 63, cgp = lane & 15;
    const bf16_t* Prkv = (const bf16_t*)(p.ws + WS_PRKV); const bf16_t* La = (const bf16_t*)(p.ws + WS_LA); const bf16_t* Lg = (const bf16_t*)(p.ws + WS_LG);
    const bf16_t* Ys = (const bf16_t*)(p.ws + WS_Y); bf16_t* YY = (bf16_t*)((unsigned char*)p.out + DO_YY);
    for (int task = bid * 8 + wave; task < M_ * 5; task += G * 8) {
        const int t = task / 5, hg = task % 5, ch = hg * 256 + lane * 4; const int tseq = t % T_;
        const bf16_t* pr = Prkv + (size_t)t * 3840 + ch;
        const u32x2 rr = *(const u32x2*)pr, kr_ = *(const u32x2*)(pr + 1280), vr = *(const u32x2*)(pr + 2560);
        u32x2 rp = {0u, 0u}, kp = rp, vp = rp;
        if (tseq > 0) { rp = *(const u32x2*)(pr - 3840); kp = *(const u32x2*)(pr - 3840 + 1280); vp = *(const u32x2*)(pr - 3840 + 2560); }
        const u32x2 a2 = *(const u32x2*)(La + (size_t)t * 1280 + ch), g2 = *(const u32x2*)(Lg + (size_t)t * 1280 + ch), y2 = *(const u32x2*)(Ys + (size_t)t * 1280 + ch);
        const f32x4 r0 = {bflo(rr.x), bfhi(rr.x), bflo(rr.y), bfhi(rr.y)}, r1 = {bflo(rp.x), bfhi(rp.x), bflo(rp.y), bfhi(rp.y)};
        const f32x4 k0 = {bflo(kr_.x), bfhi(kr_.x), bflo(kr_.y), bfhi(kr_.y)}, k1 = {bflo(kp.x), bfhi(kp.x), bflo(kp.y), bfhi(kp.y)};
        const f32x4 v0 = {bflo(vr.x), bfhi(vr.x), bflo(vr.y), bfhi(vr.y)}, v1 = {bflo(vp.x), bfhi(vp.x), bflo(vp.y), bfhi(vp.y)};
        const f32x4 av = {bflo(a2.x), bfhi(a2.x), bflo(a2.y), bfhi(a2.y)}, gv = {bflo(g2.x), bfhi(g2.x), bflo(g2.y), bfhi(g2.y)}, yv = {bflo(y2.x), bfhi(y2.x), bflo(y2.y), bfhi(y2.y)};
        const f32x4 mu_r = *(const f32x4*)(p.in[8] + ch), mu_k = *(const f32x4*)(p.in[9] + ch), mu_v = *(const f32x4*)(p.in[10] + ch);
        const f32x4 k_a = *(const f32x4*)(p.in[20] + ch), r_k = *(const f32x4*)(p.in[21] + ch), gng = *(const f32x4*)(p.in[22] + ch), gnb = *(const f32x4*)(p.in[23] + ch);
        const f32x4 r = r0 + (r1 - r0) * mu_r, k = k0 + (k1 - k0) * mu_k, v = v0 + (v1 - v0) * mu_v;
        const f32x4 k2 = k * (1.0f + (av - 1.0f) * k_a);
        const f32x4 rk4 = r * k2 * r_k;
        float rk = red16((rk4[0] + rk4[1]) + (rk4[2] + rk4[3]));
        float mu = red16((yv[0] + yv[1]) + (yv[2] + yv[3])) * (1.0f / 64.0f);
        const f32x4 yc = yv - mu;
        float var = red16((yc[0] * yc[0] + yc[1] * yc[1]) + (yc[2] * yc[2] + yc[3] * yc[3])) * (1.0f / 64.0f);
        const float rstd = 1.0f / sqrtf(var + GN_EPS_);
        const f32x4 o = (yc * rstd * gng + gnb + v * rk) * gv;
        u32x2 w; w.x = cvt_pk_bf16(o[0], o[1]); w.y = cvt_pk_bf16(o[2], o[3]);
        *(u32x2*)(YY + (size_t)t * D_ + ch) = w;
    }
    const bf16_t* Og = (const bf16_t*)(p.ws + WS_O); const float* lse = (const float*)(p.ws + WS_LSE);
    for (int task = bid * 8 + wave; task < M_ * 3; task += G * 8) {
        const int t = task / 3, hg = task % 3, hh = hg * 4 + (lane >> 4), c = hh * 64 + cgp * 4;
        const float l0 = lse[(size_t)t * NHA_ + hh], l1 = lse[(size_t)M_ * NHA_ + (size_t)t * NHA_ + hh], l2 = lse[(size_t)2 * M_ * NHA_ + (size_t)t * NHA_ + hh];
        const float lm = fmaxf(l0, fmaxf(l1, l2)); const float e0 = __expf(l0 - lm), e1 = __expf(l1 - lm), e2 = __expf(l2 - lm); const float inv = 1.0f / (e0 + e1 + e2);
        const u32x2 o0 = *(const u32x2*)(Og + (size_t)t * AD_ + c), o1 = *(const u32x2*)(Og + (size_t)M_ * AD_ + (size_t)t * AD_ + c), o2 = *(const u32x2*)(Og + (size_t)2 * M_ * AD_ + (size_t)t * AD_ + c);
        const f32x4 a0 = {bflo(o0.x), bfhi(o0.x), bflo(o0.y), bfhi(o0.y)}, a1 = {bflo(o1.x), bfhi(o1.x), bflo(o1.y), bfhi(o1.y)}, a2 = {bflo(o2.x), bfhi(o2.x), bflo(o2.y), bfhi(o2.y)};
        const f32x4 o = (a0 * e0 + a1 * e1 + a2 * e2) * inv;
        u32x2 w; w.x = cvt_pk_bf16(o[0], o[1]); w.y = cvt_pk_bf16(o[2], o[3]);
        *(u32x2*)(YY + (size_t)t * D_ + RW_ + c) = w;
    }
}

__global__ void __launch_bounds__(512, 2) fwd_kernel(Params p) {
    extern __shared__ __attribute__((aligned(16))) unsigned char lds_raw[];
    cg::grid_group grid = cg::this_grid();
    LAS unsigned char* ldsl = (LAS unsigned char*)lds_raw;
    const int bid = blockIdx.x, G = gridDim.x;
    unsigned char* ws = p.ws;
    const int lo = p.ph_lo, hi = p.ph_hi;
#define IN(k) (lo <= (k) && (k) < hi)
#define GSYNC() do { __builtin_amdgcn_fence(__ATOMIC_RELEASE, "agent"); asm volatile("s_waitcnt vmcnt(0) lgkmcnt(0)" ::: "memory"); grid.sync(); __builtin_amdgcn_fence(__ATOMIC_ACQUIRE, "agent"); asm volatile("s_waitcnt vmcnt(0)" ::: "memory"); } while (0)
#define SEAM(k) do { if (IN(k) && IN((k) + 1)) GSYNC(); } while (0)
    bf16_t* Xb = (bf16_t*)(ws + WS_XB); bf16_t* Hh = (bf16_t*)(ws + WS_H); float* Hf = (float*)(ws + WS_HF);
    bf16_t* Wgu = (bf16_t*)(ws + WS_WGU); bf16_t* Wd = (bf16_t*)(ws + WS_WD);

    if (IN(0)) { phase_convert0(p, lds_raw, bid, G); } SEAM(0);
    if (IN(1)) { pg8::Gemm g{Xb, Wgu, M_, 2 * FF_, D_, D_, D_}; pg8::StaticOrder S; S.init(M_, 2 * FF_, G, bid); EpiSwiGLU E{Hh, FF_}; pg8::gemm_phase(ldsl, g, S, E); } SEAM(1);
    if (IN(2)) { pg8::Gemm g{Hh, Wd, M_, D_, FF_, FF_, FF_}; pg8::StaticOrder S; S.init(M_, D_, G, bid); EpiRes E{p.out, p.in[0], D_, ALPHA_, 0.5f}; pg8::gemm_phase(ldsl, g, S, E); } SEAM(2);
    if (IN(3)) { ln_phase(p.out, p.in[5], p.in[6], Hf, Xb, bid, G); } SEAM(3);
    if (IN(4)) {
        pg8::Gemm g{Xb, (bf16_t*)(ws + WS_WIN), M_, NIN_, D_, D_, D_}; pg8::StaticOrder S; S.init(M_, NIN_, G, bid);
        EpiWin E{ws, (long)((unsigned char*)p.out - ws)};
        pg8::gemm_phase(ldsl, g, S, E);
    } SEAM(4);
    if (IN(5)) { phase_prep(p, lds_raw, bid, G); } SEAM(5);
    if (IN(6)) { lora_phase(p, lds_raw, 0, 2, bid, G); } SEAM(6);
    if (IN(7)) { phase_scan_attn(p, lds_raw, bid, G); } SEAM(7);
    if (IN(8)) { lora_phase(p, lds_raw, 2, 3, bid, G); } SEAM(8);
    if (IN(9)) { phase_post(p, bid, G); } SEAM(9);
    if (IN(10)) { pg8::Gemm g{(bf16_t*)((unsigned char*)p.out + DO_YY), (bf16_t*)(ws + WS_WOUT), M_, D_, D_, D_, D_}; pg8::StaticOrder S; S.init(M_, D_, G, bid); EpiRes E{(float*)(ws + WS_Z2), Hf, D_, ALPHA_, 1.0f}; pg8::gemm_phase(ldsl, g, S, E); } SEAM(10);
    if (IN(11)) { ln_phase((const float*)(ws + WS_Z2), p.in[25], p.in[26], Hf, Xb, bid, G); convert_ffn_weights(p, 27, 28, 29, (float*)lds_raw, bid, G); } SEAM(11);
    if (IN(12)) { pg8::Gemm g{Xb, Wgu, M_, 2 * FF_, D_, D_, D_}; pg8::StaticOrder S; S.init(M_, 2 * FF_, G, bid); EpiSwiGLU E{Hh, FF_}; pg8::gemm_phase(ldsl, g, S, E); } SEAM(12);
    if (IN(13)) { pg8::Gemm g{Hh, Wd, M_, D_, FF_, FF_, FF_}; pg8::StaticOrder S; S.init(M_, D_, G, bid); EpiRes E{p.out, Hf, D_, ALPHA_, 0.5f}; pg8::gemm_phase(ldsl, g, S, E); } SEAM(13);
    if (IN(14)) { ln_phase(p.out, p.in[30], p.in[31], p.out, nullptr, bid, G); }
#undef IN
#undef SEAM
}

extern "C" void kernel_launch(void* const* d_in, const int* in_sizes, int n_in, void* d_out, int out_size, void* d_ws, size_t ws_size, hipStream_t stream) {
    static int grid_blocks = 0;
    if (grid_blocks == 0) {
        int dev = 0, cus = 0, per_cu = 0;
        hipGetDevice(&dev);
        hipDeviceGetAttribute(&cus, hipDeviceAttributeMultiprocessorCount, dev);
        if (hipFuncSetAttribute((const void*)fwd_kernel, hipFuncAttributeMaxDynamicSharedMemorySize, LDS_BYTES) != hipSuccess) { fprintf(stderr, "hipFuncSetAttribute failed\n"); }
        if (hipOccupancyMaxActiveBlocksPerMultiprocessor(&per_cu, (const void*)fwd_kernel, 512, LDS_BYTES) != hipSuccess || per_cu < 1) { fprintf(stderr, "occupancy query: %d\n", per_cu); per_cu = 1; }
        (void)hipGetLastError();
        grid_blocks = cus * 1;
        if (ws_size < 512 * MiB || n_in != 32) fprintf(stderr, "kernel_launch: unexpected ws_size %zu / n_in %d\n", ws_size, n_in);
    }
    Params p{};
    for (int i = 0; i < 32; ++i) p.in[i] = (const float*)d_in[i];
    p.out = (float*)d_out; p.ws = (unsigned char*)d_ws;
#if N_LAUNCH_MODE == 1
    p.ph_lo = 0; p.ph_hi = NPHASE;
    void* args[] = {&p};
    hipError_t e = hipLaunchCooperativeKernel((const void*)fwd_kernel, dim3(grid_blocks), dim3(512), args, LDS_BYTES, stream);
    if (e != hipSuccess) fprintf(stderr, "cooperative launch failed: %s (grid %d)\n", hipGetErrorString(e), grid_blocks);
#else
    for (int ph = 0; ph < NPHASE; ++ph) {
        p.ph_lo = ph; p.ph_hi = ph + 1;
        void* args[] = {&p};
        hipError_t e = hipLaunchCooperativeKernel((const void*)fwd_kernel, dim3(grid_blocks), dim3(512), args, LDS_BYTES, stream);
        if (e != hipSuccess) { fprintf(stderr, "launch %d failed: %s (grid %d)\n", ph, hipGetErrorString(e), grid_blocks); break; }
    }
#endif
}
```

```cpp
#include <hip/hip_runtime.h>
#include <hip/hip_cooperative_groups.h>
#include <cstdio>
namespace cg = cooperative_groups;

#ifndef N_LAUNCH_MODE
#define N_LAUNCH_MODE 1
#endif

#define LAS __attribute__((address_space(3)))
typedef unsigned short bf16_t;
typedef short bf16x8 __attribute__((ext_vector_type(8)));
typedef float f32x4 __attribute__((ext_vector_type(4)));
typedef float f32x2 __attribute__((ext_vector_type(2)));
typedef unsigned u32x4 __attribute__((ext_vector_type(4)));
typedef unsigned u32x2 __attribute__((ext_vector_type(2)));

constexpr int T_ = 8192, B_ = 2, M_ = B_ * T_, D_ = 2048, FF_ = 5632;
constexpr int RW_ = 1280, NHR_ = 20, NHA_ = 12, AD_ = 768;
constexpr int NIN_ = 6656;
constexpr float ALPHA_ = 1.189207115002721f;
constexpr float LN_EPS_ = 1e-5f, GN_EPS_ = 64e-5f;
constexpr int NPHASE = 15;
constexpr int LDS_BYTES = 131072;

constexpr size_t MiB = 1048576ull;
constexpr size_t WS_HF = 0;
constexpr size_t WS_WIN = 128 * MiB;
constexpr size_t WS_WOUT = 154 * MiB;
constexpr size_t WS_WLORA = 290 * MiB + 262144;
constexpr size_t WS_WGU = 164 * MiB;
constexpr size_t WS_WD = 208 * MiB;
constexpr size_t WS_XB = 230 * MiB;
constexpr size_t WS_H = 294 * MiB;
constexpr size_t WS_PRKV = 294 * MiB;
constexpr size_t WS_PLORA = 438 * MiB;
constexpr size_t WS_PV = 470 * MiB;
constexpr size_t WS_XLORA = 414 * MiB;
constexpr size_t WS_LW = 164 * MiB;
constexpr size_t WS_LA = 204 * MiB;
constexpr size_t WS_LG = 164 * MiB;
constexpr size_t WS_Y = 248 * MiB;
constexpr size_t WS_LSE = 288 * MiB;
constexpr size_t WS_O = 438 * MiB;
constexpr size_t WS_Z2 = 294 * MiB;
constexpr size_t DO_PQ = 0, DO_PK = 24 * MiB, DO_VT = 48 * MiB, DO_YY = 0;

struct Params {
    const float* in[32];
    float* out;
    unsigned char* ws;
    int ph_lo, ph_hi;
};

__device__ __forceinline__ bf16_t f2bf(float f) { unsigned u = __float_as_uint(f); u += 0x7FFFu + ((u >> 16) & 1u); return (bf16_t)(u >> 16); }
__device__ __forceinline__ float bf2f(bf16_t b) { return __uint_as_float(((unsigned)b) << 16); }
__device__ __forceinline__ unsigned cvt_pk_bf16(float lo, float hi) { unsigned r; asm("v_cvt_pk_bf16_f32 %0, %1, %2" : "=v"(r) : "v"(lo), "v"(hi)); return r; }
__device__ __forceinline__ float bflo(unsigned w) { return __uint_as_float(w << 16); }
__device__ __forceinline__ float bfhi(unsigned w) { return __uint_as_float(w & 0xffff0000u); }
template <int CTRL> __device__ __forceinline__ float dppf(float x) { return __builtin_bit_cast(float, __builtin_amdgcn_update_dpp(0, __builtin_bit_cast(int, x), CTRL, 0xf, 0xf, false)); }
__device__ __forceinline__ int tidx() { int t = threadIdx.x; asm volatile("" : "+v"(t)); return t; }
__device__ __forceinline__ float red16(float x) {
    x += dppf<0xB1>(x); x += dppf<0x4E>(x); x += dppf<0x141>(x); x += dppf<0x128>(x); return x;
}
__device__ __forceinline__ float wave_sum(float x) {
#pragma unroll
    for (int o = 32; o >= 1; o >>= 1) x += __shfl_xor(x, o);
    return x;
}

namespace pg8 {
constexpr int BM = 256, BK = 64, HALF = 128, HTB = HALF * BK * 2, STAGE_BYTES = 8 * HTB, NXCD = 8, WGM = 8;
__device__ __forceinline__ int lds_byte(int r, int c) { const int st = (r >> 4) * 2 + (c >> 5), rr = r & 15, cc = c & 31, ob = rr * 64 + cc * 2; return st * 1024 + (ob ^ (((ob >> 9) & 1) << 5)); }
__device__ __forceinline__ void stage_rc(int b, int& R, int& C) { const int st = b / 1024, sb = b % 1024, swz = sb ^ (((sb >> 9) & 1) << 5); R = (st >> 1) * 16 + swz / 64; C = (st & 1) * 32 + (swz % 64) / 2; }
__device__ __forceinline__ int perm32(int rho) { const int n = rho >> 4, i = rho & 15; return 8 * (i >> 2) + 4 * n + (i & 3); }
struct Unit { int pm, pn; };
struct Gemm { const bf16_t* A; const bf16_t* Bt; int M, N, K, lda, ldb; };
struct StaticOrder {
    int nM, nN, nwg, G, c;
    __device__ void init(int M, int N, int G_, int c_) { nM = M / BM; nN = N / BM; nwg = nM * nN; G = G_; c = c_; }
    __device__ bool next(int i, Unit& u) const {
        const long L = (long)i * G + c; if (L >= nwg) return false;
        int wgid = (int)L; { const int q = nwg / NXCD, r = nwg % NXCD, xcd = wgid % NXCD, off = wgid / NXCD; wgid = (xcd < r ? xcd * (q + 1) : r * (q + 1) + (xcd - r) * q) + off; }
        const int nig = WGM * nN, gid = wgid / nig, fm = gid * WGM, gsz = (nM - fm) < WGM ? (nM - fm) : WGM;
        u.pm = fm + ((wgid % nig) % gsz); u.pn = (wgid % nig) / gsz; return true;
    }
};

template <class Epi>
__device__ __forceinline__ void gemm_phase(LAS unsigned char* lds, const Gemm g, const StaticOrder& S, const Epi& E) {
    const int tid = tidx(), wid = __builtin_amdgcn_readfirstlane(tid >> 6), lane = tid & 63, wr = wid >> 2, wc = wid & 3, fr = lane & 15, fq = lane >> 4;
    int K = g.K, lda_ = g.lda, ldb_ = g.ldb; asm volatile("" : "+s"(K), "+s"(lda_), "+s"(ldb_));
    const int nt = K / BK;
    unsigned voffA[2], voffB[2];
#pragma unroll
    for (int i = 0; i < 2; ++i) { int R, C; stage_rc(tid * 16 + i * 8192, R, C); const int Rb = Epi::PERM ? ((R & ~31) + perm32(R & 31)) : R;
        voffA[i] = (unsigned)(R * lda_ + C) * 2u; voffB[i] = (unsigned)(Rb * ldb_ + C) * 2u; }
    const size_t kstep = (size_t)(BK * 2);
    const size_t hstepA = (size_t)HALF * lda_ * 2, hstepB = (size_t)HALF * ldb_ * 2;
    const size_t tstepA = 2 * hstepA, tstepB = 2 * hstepB;
    const unsigned ldsw = (unsigned)wid * 1024u;
    const int aoff = lds_byte(wr * 64 + fr, fq * 8), boff = lds_byte(wc * 32 + fr, fq * 8);
#define PG8_SA(b, h) (((b) * 2 + (h)) * HTB)
#define PG8_SB(b, h) ((4 + (b) * 2 + (h)) * HTB)
#define PG8_STAGE(bufoff, gbase, voff) do { _Pragma("unroll") for (int _i = 0; _i < 2; ++_i) \
        __builtin_amdgcn_global_load_lds((const unsigned*)((const char*)(gbase) + (voff)[_i]), (LAS unsigned*)(lds + (bufoff) + ldsw + _i * 8192), 16, 0, 0); } while (0)
#define PG8_LDA(dst, b, h) do { _Pragma("unroll") for (int m = 0; m < 4; ++m) _Pragma("unroll") for (int k = 0; k < 2; ++k) dst[m][k] = *(const LAS bf16x8*)(lds + PG8_SA(b, h) + aoff + m * 2048 + k * 1024); } while (0)
#define PG8_LDB(dst, b, h) do { _Pragma("unroll") for (int n = 0; n < 2; ++n) _Pragma("unroll") for (int k = 0; k < 2; ++k) dst[n][k] = *(const LAS bf16x8*)(lds + PG8_SB(b, h) + boff + n * 2048 + k * 1024); } while (0)
#define PG8_MMA(ai, bj, At, Bt) do { __builtin_amdgcn_s_setprio(1); _Pragma("unroll") for (int m = 0; m < 4; ++m) _Pragma("unroll") for (int n = 0; n < 2; ++n) _Pragma("unroll") for (int k = 0; k < 2; ++k) \
        acc[ai][bj][m][n] = __builtin_amdgcn_mfma_f32_16x16x32_bf16(Bt[n][k], At[m][k], acc[ai][bj][m][n], 0, 0, 0); __builtin_amdgcn_s_setprio(0); } while (0)
#define PG8_WAIT_V(n) asm volatile("s_waitcnt vmcnt(" #n ")" ::: "memory")
#define PG8_WAIT_L(n) asm volatile("s_waitcnt lgkmcnt(" #n ")" ::: "memory")
#define PG8_BAR __builtin_amdgcn_s_barrier()
#define PG8_SCHED __builtin_amdgcn_sched_barrier(0)
    Unit cur, nxt; int ui = 0;
    if (!S.next(0, cur)) return;
    f32x4 acc[2][2][4][2];
#pragma unroll
    for (int a = 0; a < 2; ++a)
#pragma unroll
        for (int b = 0; b < 2; ++b)
#pragma unroll
            for (int m = 0; m < 4; ++m)
#pragma unroll
                for (int n = 0; n < 2; ++n) acc[a][b][m][n] = (f32x4){0.f, 0.f, 0.f, 0.f};
    bf16x8 At[4][2], B0[2][2], B1[2][2];
    const char* cA = (const char*)g.A + (size_t)cur.pm * tstepA; const char* cB = (const char*)g.Bt + (size_t)cur.pn * tstepB;
    PG8_STAGE(PG8_SB(0, 0), cB, voffB); PG8_STAGE(PG8_SA(0, 0), cA, voffA); PG8_STAGE(PG8_SB(0, 1), cB + hstepB, voffB); PG8_STAGE(PG8_SA(0, 1), cA + hstepA, voffA);
    if (wr == 1) PG8_BAR;
    PG8_WAIT_V(4); PG8_BAR;
    PG8_STAGE(PG8_SB(1, 0), cB + kstep, voffB); PG8_STAGE(PG8_SA(1, 0), cA + kstep, voffA); PG8_STAGE(PG8_SB(1, 1), cB + hstepB + kstep, voffB);
    PG8_WAIT_V(6); PG8_BAR;
    for (;;) {
        const bool has_next = S.next(ui + 1, nxt);
        const char* nA = has_next ? (const char*)g.A + (size_t)nxt.pm * tstepA : cA; const char* nB = has_next ? (const char*)g.Bt + (size_t)nxt.pn * tstepB : cB;
        for (int t = 0; t < nt; t += 2) {
            const bool last = (t == nt - 2);
            const char* a1 = cA + (size_t)(t + 1) * kstep;
            const char* a2 = last ? nA : cA + (size_t)(t + 2) * kstep; const char* b2 = last ? nB : cB + (size_t)(t + 2) * kstep;
            const char* a3 = a2 + kstep; const char* b3 = b2 + kstep;
            PG8_LDB(B0, 0, 0); PG8_SCHED; PG8_LDA(At, 0, 0); PG8_STAGE(PG8_SA(1, 1), a1 + hstepA, voffA);
            PG8_WAIT_L(8); PG8_BAR; PG8_WAIT_L(0); PG8_MMA(0, 0, At, B0); PG8_BAR; PG8_SCHED;
            PG8_LDB(B1, 0, 1); PG8_STAGE(PG8_SB(0, 0), b2, voffB);
            PG8_BAR; PG8_WAIT_L(0); PG8_MMA(0, 1, At, B1); PG8_BAR;
            PG8_LDA(At, 0, 1); PG8_STAGE(PG8_SA(0, 0), a2, voffA);
            PG8_BAR; PG8_WAIT_L(0); PG8_MMA(1, 0, At, B0); PG8_BAR; PG8_SCHED;
            PG8_STAGE(PG8_SB(0, 1), b2 + hstepB, voffB);
            PG8_WAIT_V(6); PG8_BAR; PG8_MMA(1, 1, At, B1); PG8_BAR;
            PG8_LDB(B0, 1, 0); PG8_SCHED; PG8_LDA(At, 1, 0); PG8_STAGE(PG8_SA(0, 1), a2 + hstepA, voffA);
            PG8_WAIT_L(8); PG8_BAR; PG8_WAIT_L(0); PG8_MMA(0, 0, At, B0); PG8_BAR; PG8_SCHED;
            PG8_LDB(B1, 1, 1); PG8_STAGE(PG8_SB(1, 0), b3, voffB);
            PG8_BAR; PG8_WAIT_L(0); PG8_MMA(0, 1, At, B1); PG8_BAR;
            PG8_LDA(At, 1, 1); PG8_STAGE(PG8_SA(1, 0), a3, voffA);
            PG8_BAR; PG8_WAIT_L(0); PG8_MMA(1, 0, At, B0); PG8_BAR; PG8_SCHED;
            PG8_STAGE(PG8_SB(1, 1), b3 + hstepB, voffB);
            PG8_WAIT_V(6); PG8_BAR; PG8_MMA(1, 1, At, B1); PG8_BAR;
        }
        E(acc, cur, wr, wc, fr, fq);
        if (!has_next) break;
#pragma unroll
        for (int a = 0; a < 2; ++a)
#pragma unroll
            for (int b = 0; b < 2; ++b)
#pragma unroll
                for (int m = 0; m < 4; ++m)
#pragma unroll
                    for (int n = 0; n < 2; ++n) acc[a][b][m][n] = (f32x4){0.f, 0.f, 0.f, 0.f};
        cur = nxt; cA = nA; cB = nB; ++ui;
    }
    PG8_WAIT_V(0);
    if (wr == 0) PG8_BAR;
    PG8_BAR;
#undef PG8_SA
#undef PG8_SB
#undef PG8_STAGE
#undef PG8_LDA
#undef PG8_LDB
#undef PG8_MMA
#undef PG8_WAIT_V
#undef PG8_WAIT_L
#undef PG8_BAR
#undef PG8_SCHED
}
}

typedef f32x4 AccT[2][2][4][2];

__device__ __forceinline__ float silu_f(float x) { return x * __builtin_amdgcn_rcpf(1.0f + __expf(-x)); }

struct EpiSwiGLU {
    static constexpr bool PERM = true;
    bf16_t* H; int ldc;
    __device__ __forceinline__ void operator()(const AccT& acc, const pg8::Unit& u, int wr, int wc, int fr, int fq) const {
        asm volatile("" : "+v"(fr), "+v"(fq));
        const int row0 = u.pm * 256 + wr * 64 + fr, col0 = u.pn * 128 + wc * 32 + 8 * fq;
#pragma unroll
        for (int ai = 0; ai < 2; ++ai)
#pragma unroll
            for (int m = 0; m < 4; ++m) {
                bf16_t* rowp = H + (size_t)(row0 + ai * 128 + m * 16) * ldc + col0;
                const f32x4 g0 = acc[ai][0][m][0], g1 = acc[ai][0][m][1], u0 = acc[ai][1][m][0], u1 = acc[ai][1][m][1];
                u32x4 w;
                w.x = cvt_pk_bf16(silu_f(g0[0]) * u0[0], silu_f(g0[1]) * u0[1]); w.y = cvt_pk_bf16(silu_f(g0[2]) * u0[2], silu_f(g0[3]) * u0[3]);
                w.z = cvt_pk_bf16(silu_f(g1[0]) * u1[0], silu_f(g1[1]) * u1[1]); w.w = cvt_pk_bf16(silu_f(g1[2]) * u1[2], silu_f(g1[3]) * u1[3]);
                *(u32x4*)rowp = w;
            }
    }
};
struct EpiRes {
    static constexpr bool PERM = false;
    float* Z; const float* res; int ldc; float alpha, scale;
    __device__ __forceinline__ void operator()(const AccT& acc, const pg8::Unit& u, int wr, int wc, int fr, int fq) const {
        asm volatile("" : "+v"(fr), "+v"(fq));
        const int row0 = u.pm * 256 + wr * 64 + fr, col0 = u.pn * 256 + wc * 32 + 4 * fq;
#pragma unroll
        for (int ai = 0; ai < 2; ++ai)
#pragma unroll
            for (int m = 0; m < 4; ++m) {
                const size_t off = (size_t)(row0 + ai * 128 + m * 16) * ldc + col0;
#pragma unroll
                for (int bj = 0; bj < 2; ++bj)
#pragma unroll
                    for (int n = 0; n < 2; ++n) {
                        const f32x4 r = *(const f32x4*)(res + off + bj * 128 + n * 16);
                        *(f32x4*)(Z + off + bj * 128 + n * 16) = r * alpha + acc[ai][bj][m][n] * scale;
                    }
            }
    }
};
struct EpiWin {
    static constexpr bool PERM = true;
    unsigned char* ws; long delta;
    __device__ __forceinline__ void operator()(const AccT& acc, const pg8::Unit& u, int wr, int wc, int fr, int fq) const {
        asm volatile("" : "+v"(fr), "+v"(fq));
        const int row0 = u.pm * 256 + wr * 64 + fr, cl = wc * 32 + 8 * fq;
        if (u.pn == 15 || u.pn == 16) {
            const int colt = (u.pn - 15) * 256 + cl;
            float* Plora = (float*)(ws + WS_PLORA);
#pragma unroll
            for (int ai = 0; ai < 2; ++ai)
#pragma unroll
                for (int m = 0; m < 4; ++m) {
                    float* rowp = Plora + (size_t)(row0 + ai * 128 + m * 16) * 512 + colt;
#pragma unroll
                    for (int bj = 0; bj < 2; ++bj)
#pragma unroll
                        for (int n = 0; n < 2; ++n) *(f32x4*)(rowp + bj * 128 + n * 4) = acc[ai][bj][m][n];
                }
        } else {
            size_t boff; int ldc, colt; bool inws = true;
            if (u.pn < 15) { boff = WS_PRKV; ldc = 3840; colt = u.pn * 256; }
            else { const int t = (u.pn - 17) / 3; inws = (t == 2); boff = (t == 0) ? DO_PQ : (t == 1 ? DO_PK : WS_PV); ldc = 768; colt = ((u.pn - 17) % 3) * 256; }
            bf16_t* base = (bf16_t*)(ws + (long)boff + (inws ? 0l : delta));
#pragma unroll
            for (int ai = 0; ai < 2; ++ai)
#pragma unroll
                for (int m = 0; m < 4; ++m) {
                    bf16_t* rowp = base + (size_t)(row0 + ai * 128 + m * 16) * ldc + colt + cl;
#pragma unroll
                    for (int bj = 0; bj < 2; ++bj) {
                        const f32x4 v0 = acc[ai][bj][m][0], v1 = acc[ai][bj][m][1];
                        u32x4 w; w.x = cvt_pk_bf16(v0[0], v0[1]); w.y = cvt_pk_bf16(v0[2], v0[3]); w.z = cvt_pk_bf16(v1[0], v1[1]); w.w = cvt_pk_bf16(v1[2], v1[3]);
                        *(u32x4*)(rowp + bj * 128) = w;
                    }
                }
        }
    }
};
__device__ __forceinline__ int map_row(int n, int mode) {
    if (mode == 1) return (n >> 7) * 256 + (n & 127);
    if (mode == 2) return (n >> 7) * 256 + 128 + (n & 127);
    if (mode == 3) return n < 4288 ? n : n + 64;
    return n;
}
__device__ void convert_weight(const float* __restrict__ W, int K, int N, bf16_t* __restrict__ Wt, int ldk, int mode, float* tile, int bid, int G) {
    const int tid = tidx(), kr = tid >> 4, nc = (tid & 15) * 4, kp = tid & 31, nr = tid >> 5;
    const int tn_n = N / 64, tn_k = K / 64, ntile = tn_n * tn_k;
    int t = bid; if (t >= ntile) return;
    f32x4 v0, v1;
    { const int tk = t / tn_n, tn = t % tn_n; const float* src = W + (size_t)(tk * 64 + kr) * N + tn * 64 + nc; v0 = *(const f32x4*)src; v1 = *(const f32x4*)(src + (size_t)32 * N); }
    while (t < ntile) {
        const int tk = t / tn_n, tn = t % tn_n, tnext = t + G;
        const f32x4 c0 = v0, c1 = v1;
        if (tnext < ntile) { const int tk2 = tnext / tn_n, tn2 = tnext % tn_n; const float* src = W + (size_t)(tk2 * 64 + kr) * N + tn2 * 64 + nc; v0 = *(const f32x4*)src; v1 = *(const f32x4*)(src + (size_t)32 * N); }
#pragma unroll
        for (int j = 0; j < 4; ++j) { tile[kr * 65 + nc + j] = c0[j]; tile[(32 + kr) * 65 + nc + j] = c1[j]; }
        __syncthreads();
        const int drow0 = map_row(tn * 64, mode);
#pragma unroll
        for (int i = 0; i < 4; ++i) { const int n = nr + 16 * i; const float a = tile[(2 * kp) * 65 + n], bq = tile[(2 * kp + 1) * 65 + n];
            *(unsigned*)(Wt + (size_t)(drow0 + n) * ldk + tk * 64 + 2 * kp) = cvt_pk_bf16(a, bq); }
        __syncthreads();
        t = tnext;
    }
}
__device__ void convert_ffn_weights(const Params& p, int ig, int iu, int idn, float* tile, int bid, int G) {
    bf16_t* Wgu = (bf16_t*)(p.ws + WS_WGU); bf16_t* Wd = (bf16_t*)(p.ws + WS_WD);
    convert_weight(p.in[ig], D_, FF_, Wgu, D_, 1, tile, bid, G);
    convert_weight(p.in[iu], D_, FF_, Wgu, D_, 2, tile, (bid + 85) % G, G);
    convert_weight(p.in[idn], FF_, D_, Wd, FF_, 0, tile, (bid + 170) % G, G);
}

__device__ void ln_phase(const float* __restrict__ Z, const float* __restrict__ gam, const float* __restrict__ bet, float* outf, bf16_t* outb, int bid, int G) {
    const int tid = tidx(), wave = tid >> 6, lane = tid & 63;
    f32x4 gv[8], bv[8];
#pragma unroll
    for (int i = 0; i < 8; ++i) { gv[i] = *(const f32x4*)(gam + i * 256 + lane * 4); bv[i] = *(const f32x4*)(bet + i * 256 + lane * 4); }
    for (int row = bid * 8 + wave; row < M_; row += G * 8) {
        const float* zr = Z + (size_t)row * D_;
        f32x4 x[8]; float s = 0.f;
#pragma unroll
        for (int i = 0; i < 8; ++i) { x[i] = *(const f32x4*)(zr + i * 256 + lane * 4); s += (x[i][0] + x[i][1]) + (x[i][2] + x[i][3]); }
        s = wave_sum(s); const float mean = s * (1.0f / D_);
        float q = 0.f;
#pragma unroll
        for (int i = 0; i < 8; ++i) { x[i] = x[i] - mean; q += (x[i][0] * x[i][0] + x[i][1] * x[i][1]) + (x[i][2] * x[i][2] + x[i][3] * x[i][3]); }
        q = wave_sum(q); const float rstd = 1.0f / sqrtf(q * (1.0f / D_) + LN_EPS_);
#pragma unroll
        for (int i = 0; i < 8; ++i) {
            const f32x4 o = x[i] * rstd * gv[i] + bv[i];
            if (outf) *(f32x4*)(outf + (size_t)row * D_ + i * 256 + lane * 4) = o;
            if (outb) { u32x2 w; w.x = cvt_pk_bf16(o[0], o[1]); w.y = cvt_pk_bf16(o[2], o[3]); *(u32x2*)(outb + (size_t)row * D_ + i * 256 + lane * 4) = w; }
        }
    }
}

__device__ void phase_convert0(const Params& p, unsigned char* lds, int bid, int G) {
    float* tile = (float*)lds;
    const int tid = tidx();
    convert_ffn_weights(p, 2, 3, 4, tile, bid, G);
    convert_weight(p.in[7], D_, 6592, (bf16_t*)(p.ws + WS_WIN), D_, 3, tile, bid, G);
    convert_weight(p.in[24], D_, D_, (bf16_t*)(p.ws + WS_WOUT), D_, 0, tile, (bid + 128) % G, G);
    { unsigned* z = (unsigned*)((bf16_t*)(p.ws + WS_WIN) + (size_t)4288 * D_); for (int i = bid * 512 + tid; i < 64 * D_ / 2; i += G * 512) z[i] = 0u; }
    { const f32x4* x4 = (const f32x4*)p.in[0]; u32x2* o = (u32x2*)(p.ws + WS_XB);
      for (int i = bid * 512 + tid; i < M_ * D_ / 4; i += G * 512) { const f32x4 v = x4[i]; u32x2 w; w.x = cvt_pk_bf16(v[0], v[1]); w.y = cvt_pk_bf16(v[2], v[3]); o[i] = w; } }
}

__device__ void phase_prep(const Params& p, unsigned char* lds, int bid, int G) {
    const int tid = tidx();
    {
        bf16_t* WL = (bf16_t*)(p.ws + WS_WLORA);
        const float* s0 = p.in[15]; const float* s1 = p.in[17]; const float* s2 = p.in[18];
        for (int i = bid * 512 + tid; i < 1280 * 256; i += G * 512) {
            const int n = i >> 8, k = i & 255;
            WL[i] = (k < 96) ? f2bf(s0[(size_t)k * 1280 + n]) : (bf16_t)0;
            WL[1280 * 256 + i] = (k < 96) ? f2bf(s1[(size_t)k * 1280 + n]) : (bf16_t)0;
            WL[2 * 1280 * 256 + i] = f2bf(s2[(size_t)k * 1280 + n]);
        }
    }
    {
        const float* PL = (const float*)(p.ws + WS_PLORA); bf16_t* XL = (bf16_t*)(p.ws + WS_XLORA);
        const float* mu_w = p.in[11]; const float* mu_a = p.in[12]; const float* mu_g = p.in[13];
        for (int i = bid * 512 + tid; i < M_ * 768; i += G * 512) {
            const int t = i / 768, c = i % 768; float o = 0.f;
            int src = -1; float mu = 0.f; int kind = 0;
            if (c < 96) { src = c; mu = mu_w[c]; kind = 0; }
            else if (c >= 256 && c < 352) { src = 96 + (c - 256); mu = mu_a[c - 256]; kind = 1; }
            else if (c >= 512) { src = 192 + (c - 512); mu = mu_g[c - 512]; kind = 2; }
            if (src >= 0) {
                const float z = PL[(size_t)t * 512 + src]; const float zp = (t % T_) ? PL[(size_t)(t - 1) * 512 + src] : 0.f;
                const float s = z + (zp - z) * mu;
                o = (kind == 0) ? tanhf(s) : (kind == 1 ? s : 1.0f / (1.0f + expf(-s)));
            }
            XL[i] = f2bf(o);
        }
    }
    {
        bf16_t* Pq = (bf16_t*)((unsigned char*)p.out + DO_PQ); bf16_t* Pk = (bf16_t*)((unsigned char*)p.out + DO_PK);
        const int* pos = (const int*)p.in[1];
        for (int i = bid * 512 + tid; i < M_ * 2 * NHA_ * 8; i += G * 512) {
            const int j = i & 7, hh = (i >> 3) % NHA_, qk = (i / (8 * NHA_)) & 1, t = i / (16 * NHA_);
            bf16_t* P = (qk ? Pk : Pq) + (size_t)t * AD_ + hh * 64;
            const float invf = exp2f(-(float)j * 2.3664460711655217f);
            const float ang = (float)pos[t] * invf; const double rv = (double)ang * 0.15915494309189535; const float rev = (float)(rv - rint(rv));
            const float sn = __builtin_amdgcn_sinf(rev), cs = __builtin_amdgcn_cosf(rev);
            const float x1 = bf2f(P[j]), x2 = bf2f(P[8 + j]);
            P[j] = f2bf(x1 * cs - x2 * sn); P[8 + j] = f2bf(x2 * cs + x1 * sn);
        }
    }
    {
        const bf16_t* Pv = (const bf16_t*)(p.ws + WS_PV); bf16_t* VT = (bf16_t*)((unsigned char*)p.out + DO_VT);
        bf16_t* tl = (bf16_t*)lds;
        for (int job = bid; job < (M_ / 256) * NHA_; job += G) {
            const int hh = job % NHA_, tb = job / NHA_, tok0 = tb * 256, b = tok0 / T_, t0 = tok0 % T_;
            __syncthreads();
            for (int i = tid; i < 256 * 32; i += 512) { const int tr = i >> 5, cp = i & 31; *(unsigned*)(tl + tr * 66 + cp * 2) = *(const unsigned*)(Pv + (size_t)(tok0 + tr) * AD_ + hh * 64 + cp * 2); }
            __syncthreads();
#pragma unroll
            for (int g = 0; g < 3; ++g) {
                const int sh = 2 * g, d = 1 << sh, per = 256 >> sh;
                bf16_t* dst = VT + (size_t)g * M_ * AD_ + ((size_t)(b * NHA_ + hh) * 64) * T_;
                for (int o = tid; o < 64 * 256; o += 512) {
                    const int e = o >> 8, j = o & 255, r = j / per, q = j % per, tloc = q * d + r;
                    dst[(size_t)e * T_ + r * (T_ >> sh) + (t0 >> sh) + q] = tl[tloc * 66 + e];
                }
            }
        }
        __syncthreads();
    }
}

__device__ __forceinline__ float lora_act(int which, float x, float c) {
    if (which == 0) { const float z = -(c + x); const float sp = fmaxf(z, 0.f) + __logf(1.0f + __expf(-fabsf(z))); return __expf(-sp - 0.5f); }
    if (which == 1) return __builtin_amdgcn_rcpf(1.0f + __expf(-(c + x)));
    return x;
}
__device__ void lora_phase(const Params& p, unsigned char* lds, int wlo, int whi, int bid, int G) {
    const int tid = tidx(), wave = tid >> 6, lane = tid & 63, rl = lane & 15, gq = lane >> 4;
    const bf16_t* XL = (const bf16_t*)(p.ws + WS_XLORA); const bf16_t* WL = (const bf16_t*)(p.ws + WS_WLORA);
    unsigned char* Ash = lds;
    unsigned char* Bsh = lds + 128 * 528;
    asm volatile("" : "+s"(wlo), "+s"(whi));
    const int nw = whi - wlo, nitem = 128 * nw * 2;
    for (int item = bid; item < nitem; item += G) {
        const int half = item & 1, which = wlo + (item >> 1) % nw, rb = (item >> 1) / nw;
        const int K = (which == 2) ? 256 : 128, koff = which * 256, cpr = K / 8;
        bf16_t* Ob = (bf16_t*)(p.ws + (which == 0 ? WS_LW : (which == 1 ? WS_LA : WS_LG)));
        const float* cvec = (which == 0) ? p.in[14] : p.in[16];
        __syncthreads();
        for (int c = tid; c < 128 * cpr; c += 512) { const int r = c / cpr, ck = c % cpr; *(u32x4*)(Ash + r * 528 + ck * 16) = *(const u32x4*)(XL + (size_t)(rb * 128 + r) * 768 + koff + ck * 8); }
        for (int cb = 0; cb < 10; ++cb) {
            const int col0 = (half * 10 + cb) * 64;
            __syncthreads();
            for (int c = tid; c < 64 * cpr; c += 512) { const int r = c / cpr, ck = c % cpr; *(u32x4*)(Bsh + r * 528 + ck * 16) = *(const u32x4*)(WL + (size_t)which * 1280 * 256 + (size_t)(col0 + r) * 256 + ck * 8); }
            __syncthreads();
            f32x4 acc[4];
#pragma unroll
            for (int nt = 0; nt < 4; ++nt) acc[nt] = (f32x4){0.f, 0.f, 0.f, 0.f};
            for (int ks = 0; ks < K / 32; ++ks) {
                const bf16x8 Af = *(const bf16x8*)(Ash + (16 * wave + rl) * 528 + ks * 64 + gq * 16);
#pragma unroll
                for (int nt = 0; nt < 4; ++nt) { const bf16x8 Bf = *(const bf16x8*)(Bsh + (16 * nt + rl) * 528 + ks * 64 + gq * 16); acc[nt] = __builtin_amdgcn_mfma_f32_16x16x32_bf16(Bf, Af, acc[nt], 0, 0, 0); }
            }
            const size_t row = (size_t)rb * 128 + 16 * wave + rl;
#pragma unroll
            for (int nt = 0; nt < 4; ++nt) {
                const int col = col0 + 16 * nt + 4 * gq; f32x4 cv = {0.f, 0.f, 0.f, 0.f};
                if (which != 2) cv = *(const f32x4*)(cvec + col);
                u32x2 w; w.x = cvt_pk_bf16(lora_act(which, acc[nt][0], cv[0]), lora_act(which, acc[nt][1], cv[1])); w.y = cvt_pk_bf16(lora_act(which, acc[nt][2], cv[2]), lora_act(which, acc[nt][3], cv[3]));
                *(u32x2*)(Ob + row * RW_ + col) = w;
            }
        }
    }
    __syncthreads();
}

__device__ void scan_unit(const Params& p, unsigned char* lds, int bh, int qd) {
    const int tid = tidx(), wave = tid >> 6, lane = tid & 63;
    const int b = bh / NHR_, h = bh % NHR_;
    float* bufX = (float*)lds;
    float* bufV = (float*)(lds + 81920);
    float* bufY = (float*)(lds + 81920 + 4096);
    const bf16_t* Prkv = (const bf16_t*)(p.ws + WS_PRKV); const bf16_t* Lw = (const bf16_t*)(p.ws + WS_LW); const bf16_t* La = (const bf16_t*)(p.ws + WS_LA);
    bf16_t* Y = (bf16_t*)(p.ws + WS_Y);
    const bool loader = wave >= 4;
    const int ts = lane >> 4, cg = lane & 15, ch = h * 64 + cg * 4;
    f32x4 mu_r = {0, 0, 0, 0}, mu_k = mu_r, mu_v = mu_r, k_k = mu_r, k_a = mu_r;
    if (loader) { mu_r = *(const f32x4*)(p.in[8] + ch); mu_k = *(const f32x4*)(p.in[9] + ch); mu_v = *(const f32x4*)(p.in[10] + ch); k_k = *(const f32x4*)(p.in[19] + ch); k_a = *(const f32x4*)(p.in[20] + ch); }
    const int lw = wave - 4;
    f32x4 S = {0.f, 0.f, 0.f, 0.f};
    const int rowl = 4 * (wave & 3) + (lane >> 4);

    struct LReg { u32x2 rr, kr, vr, rp, kp, vp, ew, av; };
#define SC_ISSUE(cc, R, gi) { const int tl_ = 4 * (lw + 4 * (gi)) + ts, tseq_ = (cc) * 32 + tl_; const size_t tok_ = (size_t)b * T_ + tseq_; const bf16_t* pr_ = Prkv + tok_ * 3840 + ch; \
        R.rr = *(const u32x2*)pr_; R.kr = *(const u32x2*)(pr_ + 1280); R.vr = *(const u32x2*)(pr_ + 2560); \
        R.rp = (u32x2){0u, 0u}; R.kp = R.rp; R.vp = R.rp; \
        if (tseq_ > 0) { R.rp = *(const u32x2*)(pr_ - 3840); R.kp = *(const u32x2*)(pr_ - 3840 + 1280); R.vp = *(const u32x2*)(pr_ - 3840 + 2560); } \
        R.ew = *(const u32x2*)(Lw + tok_ * 1280 + ch); R.av = *(const u32x2*)(La + tok_ * 1280 + ch); }
#define SC_PROC(buf_, R, gi) { const int tl_ = 4 * (lw + 4 * (gi)) + ts; \
        const f32x4 r0 = {bflo(R.rr.x), bfhi(R.rr.x), bflo(R.rr.y), bfhi(R.rr.y)}, r1 = {bflo(R.rp.x), bfhi(R.rp.x), bflo(R.rp.y), bfhi(R.rp.y)}; \
        const f32x4 k0 = {bflo(R.kr.x), bfhi(R.kr.x), bflo(R.kr.y), bfhi(R.kr.y)}, k1 = {bflo(R.kp.x), bfhi(R.kp.x), bflo(R.kp.y), bfhi(R.kp.y)}; \
        const f32x4 v0 = {bflo(R.vr.x), bfhi(R.vr.x), bflo(R.vr.y), bfhi(R.vr.y)}, v1 = {bflo(R.vp.x), bfhi(R.vp.x), bflo(R.vp.y), bfhi(R.vp.y)}; \
        const f32x4 ew = {bflo(R.ew.x), bfhi(R.ew.x), bflo(R.ew.y), bfhi(R.ew.y)}, av = {bflo(R.av.x), bfhi(R.av.x), bflo(R.av.y), bfhi(R.av.y)}; \
        const f32x4 r = r0 + (r1 - r0) * mu_r, k = k0 + (k1 - k0) * mu_k, v = v0 + (v1 - v0) * mu_v; \
        f32x4 dec; dec[0] = __builtin_amdgcn_exp2f(ew[0] * -1.4426950408889634f); dec[1] = __builtin_amdgcn_exp2f(ew[1] * -1.4426950408889634f); dec[2] = __builtin_amdgcn_exp2f(ew[2] * -1.4426950408889634f); dec[3] = __builtin_amdgcn_exp2f(ew[3] * -1.4426950408889634f); \
        const f32x4 kku = k * k_k; float s1 = (kku[0] * kku[0] + kku[1] * kku[1]) + (kku[2] * kku[2] + kku[3] * kku[3]); s1 = red16(s1); \
        const float rn = 1.0f / fmaxf(sqrtf(s1), 1e-12f); const f32x4 kk = kku * rn; const f32x4 k2 = k * (1.0f + (av - 1.0f) * k_a); \
        float* X = bufX + ((size_t)((buf_) * 32 + tl_)) * 320 + cg * 4; \
        *(f32x4*)(X) = dec; *(f32x4*)(X + 64) = -kk; *(f32x4*)(X + 128) = kk * av; *(f32x4*)(X + 192) = k2; *(f32x4*)(X + 256) = r; \
        if ((cg >> 2) == qd) *(f32x4*)(bufV + ((buf_) * 32 + tl_) * 16 + (cg & 3) * 4) = v; }
    LReg A0, A1, B0, B1;
    auto store_y = [&](int c, int buf) {
        const int lt = tid - 256, tl = lt >> 3, pr = lt & 7;
        const float y0 = bufY[(buf * 32 + tl) * 16 + 2 * pr], y1 = bufY[(buf * 32 + tl) * 16 + 2 * pr + 1];
        *(unsigned*)(Y + ((size_t)b * T_ + c * 32 + tl) * 1280 + h * 64 + 16 * qd + 2 * pr) = cvt_pk_bf16(y0, y1);
    };

    __syncthreads();
    if (loader) { SC_ISSUE(0, A0, 0); SC_ISSUE(0, A1, 1); SC_PROC(0, A0, 0); SC_PROC(0, A1, 1); SC_ISSUE(1, A0, 0); SC_ISSUE(1, A1, 1); }
    __syncthreads();
    for (int c = 0; c < T_ / 32; ++c) {
        const int buf = c & 1;
        if (!loader) {
            const float* Xc = bufX + (size_t)(buf * 32) * 320 + cg * 4;
            const float* Vc = bufV + (buf * 32) * 16 + rowl;
#define SC_LD(i, W, A, B, K, R, V) { const float* X_ = Xc + (i) * 320; W = *(const f32x4*)X_; A = *(const f32x4*)(X_ + 64); B = *(const f32x4*)(X_ + 128); K = *(const f32x4*)(X_ + 192); R = *(const f32x4*)(X_ + 256); V = Vc[(i) * 16]; }
#define SC_STEP(tt, W, A, B, K, R, V) { \
                f32x2 pa_ = (f32x2){S[0], S[1]} * (f32x2){A[0], A[1]}; pa_ = __builtin_elementwise_fma((f32x2){S[2], S[3]}, (f32x2){A[2], A[3]}, pa_); float sa = pa_.x + pa_.y; sa = red16(sa); \
                S = S * W + B * sa + K * V; \
                f32x2 py_ = (f32x2){S[0], S[1]} * (f32x2){R[0], R[1]}; py_ = __builtin_elementwise_fma((f32x2){S[2], S[3]}, (f32x2){R[2], R[3]}, py_); float y = py_.x + py_.y; y = red16(y); \
                ykeep = (cg == ((tt) & 15)) ? y : ykeep; \
                if (((tt) & 15) == 15) bufY[(buf * 32 + ((tt) - 15) + cg) * 16 + rowl] = ykeep; }
            f32x4 w0, a0, b0, k0, r0, w1, a1, b1, k1, r1, w2, a2, b2, k2, r2, w3, a3, b3, k3, r3; float v0, v1, v2, v3; float ykeep = 0.f;
            SC_LD(0, w0, a0, b0, k0, r0, v0); SC_LD(1, w1, a1, b1, k1, r1, v1);
#pragma unroll
            for (int t = 0; t < 32; t += 2) {
                SC_LD((t + 2 < 32 ? t + 2 : 31), w2, a2, b2, k2, r2, v2);
                SC_STEP(t, w0, a0, b0, k0, r0, v0);
                SC_LD((t + 3 < 32 ? t + 3 : 31), w3, a3, b3, k3, r3, v3);
                SC_STEP(t + 1, w1, a1, b1, k1, r1, v1);
                w0 = w2; a0 = a2; b0 = b2; k0 = k2; r0 = r2; v0 = v2; w1 = w3; a1 = a3; b1 = b3; k1 = k3; r1 = r3; v1 = v3;
            }
#undef SC_LD
#undef SC_STEP
        } else {
            { const int c2 = (c + 2 < T_ / 32) ? c + 2 : T_ / 32 - 1; SC_ISSUE(c2, B0, 0); SC_ISSUE(c2, B1, 1); }
            if (c + 1 < T_ / 32) { SC_PROC(buf ^ 1, A0, 0); SC_PROC(buf ^ 1, A1, 1); }
            if (c > 0) store_y(c - 1, buf ^ 1);
            A0 = B0; A1 = B1;
        }
        __syncthreads();
    }
    if (loader) store_y(T_ / 32 - 1, 1);
    __syncthreads();
}

__device__ void attn_item(const Params& p, unsigned char* lds, int item) {
    const int tid = tidx(), wave = tid >> 6, lane = tid & 63, qn = lane & 15, gq = lane >> 4;
    const int g = item / 1536, rem = item % 1536, b = rem / 768, hh = (rem >> 6) % NHA_, rn = rem & 63;
    const int sh = 2 * g, d = 1 << sh, L = T_ >> sh, nb = 64 >> sh, r = rn / nb, n = rn % nb;
    const bf16_t* Pq = (const bf16_t*)((unsigned char*)p.out + DO_PQ); const bf16_t* Pk = (const bf16_t*)((unsigned char*)p.out + DO_PK);
    const bf16_t* VT = (const bf16_t*)((unsigned char*)p.out + DO_VT) + (size_t)g * M_ * AD_ + ((size_t)(b * NHA_ + hh) * 64) * T_;
    bf16_t* Og = (bf16_t*)(p.ws + WS_O) + (size_t)g * M_ * AD_; float* lse = (float*)(p.ws + WS_LSE) + (size_t)g * M_ * NHA_;
    unsigned char* Ksh = lds;
    unsigned char* Vsh = lds + 256 * 144;
    __syncthreads();
#pragma unroll
    for (int i = 0; i < 4; ++i) {
        const int chunk = tid + 512 * i, kap = chunk >> 3, part = chunk & 7;
        const int lp = 128 * (n - 1) + kap; u32x4 val = {0u, 0u, 0u, 0u};
        if (lp >= 0) val = *(const u32x4*)(Pk + ((size_t)b * T_ + (size_t)lp * d + r) * AD_ + hh * 64 + part * 8);
        const int row = (kap & 0xE0) | (((kap >> 2) & 1) << 4) | (((kap >> 3) & 3) << 2) | (kap & 3);
        *(u32x4*)(Ksh + row * 144 + part * 16) = val;
    }
#pragma unroll
    for (int i = 0; i < 4; ++i) {
        const int chunk = tid + 512 * i, e = chunk >> 5, part = chunk & 31, k0 = part * 8;
        u32x4 val = {0u, 0u, 0u, 0u};
        if (n > 0 || k0 >= 128) val = *(const u32x4*)(VT + (size_t)e * T_ + r * L + 128 * (n - 1) + k0);
        *(u32x4*)(Vsh + e * 528 + part * 16) = val;
    }
    const int q = 16 * wave + qn; const size_t qtok = (size_t)b * T_ + (size_t)(128 * n + q) * d + r;
    const bf16x8 Q0 = *(const bf16x8*)(Pq + qtok * AD_ + hh * 64 + gq * 8), Q1 = *(const bf16x8*)(Pq + qtok * AD_ + hh * 64 + 32 + gq * 8);
    __syncthreads();
    const int s0 = wave >> 1;
    f32x4 sacc[5][2];
#pragma unroll
    for (int st = 0; st < 5; ++st)
#pragma unroll
        for (int bb = 0; bb < 2; ++bb) {
            const int row = (s0 + st) * 32 + bb * 16 + qn;
            const bf16x8 K0 = *(const bf16x8*)(Ksh + row * 144 + gq * 16), K1 = *(const bf16x8*)(Ksh + row * 144 + 64 + gq * 16);
            f32x4 a = {0.f, 0.f, 0.f, 0.f};
            a = __builtin_amdgcn_mfma_f32_16x16x32_bf16(K0, Q0, a, 0, 0, 0);
            a = __builtin_amdgcn_mfma_f32_16x16x32_bf16(K1, Q1, a, 0, 0, 0);
            sacc[st][bb] = a;
        }
    const float SC = 0.125f * 1.4426950408889634f;
    float mx = -INFINITY;
#pragma unroll
    for (int st = 0; st < 5; ++st)
#pragma unroll
        for (int bb = 0; bb < 2; ++bb)
#pragma unroll
            for (int i = 0; i < 4; ++i) {
                const int kap = 32 * (s0 + st) + 8 * gq + 4 * bb + i, rel = q + 128 - kap;
                const bool valid = (rel >= 0) && (rel <= 128) && (n > 0 || kap >= 128);
                const float sv = valid ? sacc[st][bb][i] * SC : -INFINITY;
                sacc[st][bb][i] = sv; mx = fmaxf(mx, sv);
            }
    mx = fmaxf(mx, __shfl_xor(mx, 16)); mx = fmaxf(mx, __shfl_xor(mx, 32));
    float den = 0.f; bf16x8 Pf[5];
#pragma unroll
    for (int st = 0; st < 5; ++st) {
        float pv[8];
#pragma unroll
        for (int bb = 0; bb < 2; ++bb)
#pragma unroll
            for (int i = 0; i < 4; ++i) { const float pe = __builtin_amdgcn_exp2f(sacc[st][bb][i] - mx); pv[bb * 4 + i] = pe; den += pe; }
        u32x4 w; w.x = cvt_pk_bf16(pv[0], pv[1]); w.y = cvt_pk_bf16(pv[2], pv[3]); w.z = cvt_pk_bf16(pv[4], pv[5]); w.w = cvt_pk_bf16(pv[6], pv[7]);
        Pf[st] = __builtin_bit_cast(bf16x8, w);
    }
    den += __shfl_xor(den, 16); den += __shfl_xor(den, 32);
    f32x4 oacc[4];
#pragma unroll
    for (int et = 0; et < 4; ++et) oacc[et] = (f32x4){0.f, 0.f, 0.f, 0.f};
#pragma unroll
    for (int st = 0; st < 5; ++st)
#pragma unroll
        for (int et = 0; et < 4; ++et) {
            const bf16x8 Vf = *(const bf16x8*)(Vsh + (16 * et + qn) * 528 + ((s0 + st) * 32 + 8 * gq) * 2);
            oacc[et] = __builtin_amdgcn_mfma_f32_16x16x32_bf16(Vf, Pf[st], oacc[et], 0, 0, 0);
        }
    const float inv = 1.0f / den;
#pragma unroll
    for (int et = 0; et < 4; ++et) {
        u32x2 w; w.x = cvt_pk_bf16(oacc[et][0] * inv, oacc[et][1] * inv); w.y = cvt_pk_bf16(oacc[et][2] * inv, oacc[et][3] * inv);
        *(u32x2*)(Og + qtok * AD_ + hh * 64 + 16 * et + 4 * gq) = w;
    }
    if (gq == 0) lse[qtok * NHA_ + hh] = mx * 0.6931471805599453f + logf(den);
}

__device__ void phase_scan_attn(const Params& p, unsigned char* lds, int bid, int G) {
    constexpr int NSCAN = 160, NITEM = 3 * 1536;
    if (G > NSCAN) {
        if (bid < NSCAN) { const int xcd = bid & 7, slot = bid >> 3; scan_unit(p, lds, xcd * 5 + (slot >> 2), slot & 3); }
        else { for (int it = bid - NSCAN; it < NITEM; it += G - NSCAN) attn_item(p, lds, it); }
    } else {
        for (int u = bid; u < NSCAN; u += G) scan_unit(p, lds, u >> 2, u & 3);
        for (int it = bid; it < NITEM; it += G) attn_item(p, lds, it);
    }
    __syncthreads();
}

__device__ void phase_post(const Params& p, int bid, int G) {
    const int tid = tidx(), wave = tid >> 6, lane = tid & 63, cgp = lane & 15;
    const bf16_t* Prkv = (const bf16_t*)(p.ws + WS_PRKV); const bf16_t* La = (const bf16_t*)(p.ws + WS_LA); const bf16_t* Lg = (const bf16_t*)(p.ws + WS_LG);
    const bf16_t* Ys = (const bf16_t*)(p.ws + WS_Y); bf16_t* YY = (bf16_t*)((unsigned char*)p.out + DO_YY);
    for (int task = bid * 8 + wave; task < M_ * 5; task += G * 8) {
        const int t = task / 5, hg = task % 5, ch = hg * 256 + lane * 4; const int tseq = t % T_;
        const bf16_t* pr = Prkv + (size_t)t * 3840 + ch;
        const u32x2 rr = *(const u32x2*)pr, kr_ = *(const u32x2*)(pr + 1280), vr = *(const u32x2*)(pr + 2560);
        u32x2 rp = {0u, 0u}, kp = rp, vp = rp;
        if (tseq > 0) { rp = *(const u32x2*)(pr - 3840); kp = *(const u32x2*)(pr - 3840 + 1280); vp = *(const u32x2*)(pr - 3840 + 2560); }
        const u32x2 a2 = *(const u32x2*)(La + (size_t)t * 1280 + ch), g2 = *(const u32x2*)(Lg + (size_t)t * 1280 + ch), y2 = *(const u32x2*)(Ys + (size_t)t * 1280 + ch);
        const f32x4 r0 = {bflo(rr.x), bfhi(rr.x), bflo(rr.y), bfhi(rr.y)}, r1 = {bflo(rp.x), bfhi(rp.x), bflo(rp.y), bfhi(rp.y)};
        const f32x4 k0 = {bflo(kr_.x), bfhi(kr_.x), bflo(kr_.y), bfhi(kr_.y)}, k1 = {bflo(kp.x), bfhi(kp.x), bflo(kp.y), bfhi(kp.y)};
        const f32x4 v0 = {bflo(vr.x), bfhi(vr.x), bflo(vr.y), bfhi(vr.y)}, v1 = {bflo(vp.x), bfhi(vp.x), bflo(vp.y), bfhi(vp.y)};
        const f32x4 av = {bflo(a2.x), bfhi(a2.x), bflo(a2.y), bfhi(a2.y)}, gv = {bflo(g2.x), bfhi(g2.x), bflo(g2.y), bfhi(g2.y)}, yv = {bflo(y2.x), bfhi(y2.x), bflo(y2.y), bfhi(y2.y)};
        const f32x4 mu_r = *(const f32x4*)(p.in[8] + ch), mu_k = *(const f32x4*)(p.in[9] + ch), mu_v = *(const f32x4*)(p.in[10] + ch);
        const f32x4 k_a = *(const f32x4*)(p.in[20] + ch), r_k = *(const f32x4*)(p.in[21] + ch), gng = *(const f32x4*)(p.in[22] + ch), gnb = *(const f32x4*)(p.in[23] + ch);
        const f32x4 r = r0 + (r1 - r0) * mu_r, k = k0 + (k1 - k0) * mu_k, v = v0 + (v1 - v0) * mu_v;
        const f32x4 k2 = k * (1.0f + (av - 1.0f) * k_a);
        const f32x4 rk4 = r * k2 * r_k;
        float rk = red16((rk4[0] + rk4[1]) + (rk4[2] + rk4[3]));
        float mu = red16((yv[0] + yv[1]) + (yv[2] + yv[3])) * (1.0f / 64.0f);
        const f32x4 yc = yv - mu;
        float var = red16((yc[0] * yc[0] + yc[1] * yc[1]) + (yc[2] * yc[2] + yc[3] * yc[3])) * (1.0f / 64.0f);
        const float rstd = 1.0f / sqrtf(var + GN_EPS_);
        const f32x4 o = (yc * rstd * gng + gnb + v * rk) * gv;
        u32x2 w; w.x = cvt_pk_bf16(o[0], o[1]); w.y = cvt_pk_bf16(o[2], o[3]);
        *(u32x2*)(YY + (size_t)t * D_ + ch) = w;
    }
    const bf16_t* Og = (const bf16_t*)(p.ws + WS_O); const float* lse = (const float*)(p.ws + WS_LSE);
    for (int task = bid * 8 + wave; task < M_ * 3; task += G * 8) {
        const int t = task / 3, hg = task % 3, hh = hg * 4 + (lane >> 4), c = hh * 64 + cgp * 4;
        const float l0 = lse[(size_t)t * NHA_ + hh], l1 = lse[(size_t)M_ * NHA_ + (size_t)t * NHA_ + hh], l2 = lse[(size_t)2 * M_ * NHA_ + (size_t)t * NHA_ + hh];
        const float lm = fmaxf(l0, fmaxf(l1, l2)); const float e0 = __expf(l0 - lm), e1 = __expf(l1 - lm), e2 = __expf(l2 - lm); const float inv = 1.0f / (e0 + e1 + e2);
        const u32x2 o0 = *(const u32x2*)(Og + (size_t)t * AD_ + c), o1 = *(const u32x2*)(Og + (size_t)M_ * AD_ + (size_t)t * AD_ + c), o2 = *(const u32x2*)(Og + (size_t)2 * M_ * AD_ + (size_t)t * AD_ + c);
        const f32x4 a0 = {bflo(o0.x), bfhi(o0.x), bflo(o0.y), bfhi(o0.y)}, a1 = {bflo(o1.x), bfhi(o1.x), bflo(o1.y), bfhi(o1.y)}, a2 = {bflo(o2.x), bfhi(o2.x), bflo(o2.y), bfhi(o2.y)};
        const f32x4 o = (a0 * e0 + a1 * e1 + a2 * e2) * inv;
        u32x2 w; w.x = cvt_pk_bf16(o[0], o[1]); w.y = cvt_pk_bf16(o[2], o[3]);
        *(u32x2*)(YY + (size_t)t * D_ + RW_ + c) = w;
    }
}

__global__ void __launch_bounds__(512, 2) fwd_kernel(Params p) {
    extern __shared__ __attribute__((aligned(16))) unsigned char lds_raw[];
    cg::grid_group grid = cg::this_grid();
    LAS unsigned char* ldsl = (LAS unsigned char*)lds_raw;
    const int bid = blockIdx.x, G = gridDim.x;
    unsigned char* ws = p.ws;
    const int lo = p.ph_lo, hi = p.ph_hi;
#define IN(k) (lo <= (k) && (k) < hi)
#define GSYNC() do { grid.sync(); } while (0)
#define SEAM(k) do { if (IN(k) && IN((k) + 1)) GSYNC(); } while (0)
    bf16_t* Xb = (bf16_t*)(ws + WS_XB); bf16_t* Hh = (bf16_t*)(ws + WS_H); float* Hf = (float*)(ws + WS_HF);
    bf16_t* Wgu = (bf16_t*)(ws + WS_WGU); bf16_t* Wd = (bf16_t*)(ws + WS_WD);

    if (IN(0)) { phase_convert0(p, lds_raw, bid, G); } SEAM(0);
    if (IN(1)) { pg8::Gemm g{Xb, Wgu, M_, 2 * FF_, D_, D_, D_}; pg8::StaticOrder S; S.init(M_, 2 * FF_, G, bid); EpiSwiGLU E{Hh, FF_}; pg8::gemm_phase(ldsl, g, S, E); } SEAM(1);
    if (IN(2)) { pg8::Gemm g{Hh, Wd, M_, D_, FF_, FF_, FF_}; pg8::StaticOrder S; S.init(M_, D_, G, bid); EpiRes E{p.out, p.in[0], D_, ALPHA_, 0.5f}; pg8::gemm_phase(ldsl, g, S, E); } SEAM(2);
    if (IN(3)) { ln_phase(p.out, p.in[5], p.in[6], Hf, Xb, bid, G); } SEAM(3);
    if (IN(4)) {
        pg8::Gemm g{Xb, (bf16_t*)(ws + WS_WIN), M_, NIN_, D_, D_, D_}; pg8::StaticOrder S; S.init(M_, NIN_, G, bid);
        EpiWin E{ws, (long)((unsigned char*)p.out - ws)};
        pg8::gemm_phase(ldsl, g, S, E);
    } SEAM(4);
    if (IN(5)) { phase_prep(p, lds_raw, bid, G); } SEAM(5);
    if (IN(6)) { lora_phase(p, lds_raw, 0, 2, bid, G); } SEAM(6);
    if (IN(7)) { phase_scan_attn(p, lds_raw, bid, G); } SEAM(7);
    if (IN(8)) { lora_phase(p, lds_raw, 2, 3, bid, G); } SEAM(8);
    if (IN(9)) { phase_post(p, bid, G); } SEAM(9);
    if (IN(10)) { pg8::Gemm g{(bf16_t*)((unsigned char*)p.out + DO_YY), (bf16_t*)(ws + WS_WOUT), M_, D_, D_, D_, D_}; pg8::StaticOrder S; S.init(M_, D_, G, bid); EpiRes E{(float*)(ws + WS_Z2), Hf, D_, ALPHA_, 1.0f}; pg8::gemm_phase(ldsl, g, S, E); } SEAM(10);
    if (IN(11)) { ln_phase((const float*)(ws + WS_Z2), p.in[25], p.in[26], Hf, Xb, bid, G); convert_ffn_weights(p, 27, 28, 29, (float*)lds_raw, bid, G); } SEAM(11);
    if (IN(12)) { pg8::Gemm g{Xb, Wgu, M_, 2 * FF_, D_, D_, D_}; pg8::StaticOrder S; S.init(M_, 2 * FF_, G, bid); EpiSwiGLU E{Hh, FF_}; pg8::gemm_phase(ldsl, g, S, E); } SEAM(12);
    if (IN(13)) { pg8::Gemm g{Hh, Wd, M_, D_, FF_, FF_, FF_}; pg8::StaticOrder S; S.init(M_, D_, G, bid); EpiRes E{p.out, Hf, D_, ALPHA_, 0.5f}; pg8::gemm_phase(ldsl, g, S, E); } SEAM(13);
    if (IN(14)) { ln_phase(p.out, p.in[30], p.in[31], p.out, nullptr, bid, G); }
#undef IN
#undef SEAM
}

extern "C" void kernel_launch(void* const* d_in, const int* in_sizes, int n_in, void* d_out, int out_size, void* d_ws, size_t ws_size, hipStream_t stream) {
    static int grid_blocks = 0;
    if (grid_blocks == 0) {
        int dev = 0, cus = 0, per_cu = 0;
        hipGetDevice(&dev);
        hipDeviceGetAttribute(&cus, hipDeviceAttributeMultiprocessorCount, dev);
        if (hipFuncSetAttribute((const void*)fwd_kernel, hipFuncAttributeMaxDynamicSharedMemorySize, LDS_BYTES) != hipSuccess) { fprintf(stderr, "hipFuncSetAttribute failed\n"); }
        if (hipOccupancyMaxActiveBlocksPerMultiprocessor(&per_cu, (const void*)fwd_kernel, 512, LDS_BYTES) != hipSuccess || per_cu < 1) { fprintf(stderr, "occupancy query: %d\n", per_cu); per_cu = 1; }
        (void)hipGetLastError();
        grid_blocks = cus * 1;
        if (ws_size < 512 * MiB || n_in != 32) fprintf(stderr, "kernel_launch: unexpected ws_size %zu / n_in %d\n", ws_size, n_in);
    }
    Params p{};
    for (int i = 0; i < 32; ++i) p.in[i] = (const float*)d_in[i];
    p.out = (float*)d_out; p.ws = (unsigned char*)d_ws;
#if N_LAUNCH_MODE == 1
    p.ph_lo = 0; p.ph_hi = NPHASE;
    void* args[] = {&p};
    hipError_t e = hipLaunchCooperativeKernel((const void*)fwd_kernel, dim3(grid_blocks), dim3(512), args, LDS_BYTES, stream);
    if (e != hipSuccess) fprintf(stderr, "cooperative launch failed: %s (grid %d)\n", hipGetErrorString(e), grid_blocks);
#else
    for (int ph = 0; ph < NPHASE; ++ph) {
        p.ph_lo = ph; p.ph_hi = ph + 1;
        void* args[] = {&p};
        hipError_t e = hipLaunchCooperativeKernel((const void*)fwd_kernel, dim3(grid_blocks), dim3(512), args, LDS_BYTES, stream);
        if (e != hipSuccess) { fprintf(stderr, "launch %d failed: %s (grid %d)\n", ph, hipGetErrorString(e), grid_blocks); break; }
    }
#endif
}
```

```cpp
#include <hip/hip_runtime.h>
#include <hip/hip_cooperative_groups.h>
#include <cstdio>
namespace cg = cooperative_groups;

#ifndef N_LAUNCH_MODE
#define N_LAUNCH_MODE 1
#endif

#define LAS __attribute__((address_space(3)))
typedef unsigned short bf16_t;
typedef short bf16x8 __attribute__((ext_vector_type(8)));
typedef float f32x4 __attribute__((ext_vector_type(4)));
typedef float f32x2 __attribute__((ext_vector_type(2)));
typedef unsigned u32x4 __attribute__((ext_vector_type(4)));
typedef unsigned u32x2 __attribute__((ext_vector_type(2)));

constexpr int T_ = 8192, B_ = 2, M_ = B_ * T_, D_ = 2048, FF_ = 5632;
constexpr int RW_ = 1280, NHR_ = 20, NHA_ = 12, AD_ = 768;
constexpr int NIN_ = 6656;
constexpr float ALPHA_ = 1.189207115002721f;
constexpr float LN_EPS_ = 1e-5f, GN_EPS_ = 64e-5f;
constexpr int NPHASE = 15;
constexpr int LDY_ = 2048 + 128;
constexpr int LDS_BYTES = 131072;

constexpr size_t MiB = 1048576ull;
constexpr size_t WS_HF = 0;
constexpr size_t WS_WIN = 128 * MiB;
constexpr size_t WS_WOUT = 154 * MiB;
constexpr size_t WS_WLORA = 290 * MiB + 262144;
constexpr size_t WS_WGU = 164 * MiB;
constexpr size_t WS_WD = 208 * MiB;
constexpr size_t WS_XB = 230 * MiB;
constexpr size_t WS_H = 294 * MiB;
constexpr size_t WS_PRKV = 294 * MiB;
constexpr size_t WS_PLORA = 438 * MiB;
constexpr size_t WS_PV = 470 * MiB;
constexpr size_t WS_XLORA = 414 * MiB;
constexpr size_t WS_LW = 164 * MiB;
constexpr size_t WS_LA = 204 * MiB;
constexpr size_t WS_LG = 164 * MiB;
constexpr size_t WS_Y = 248 * MiB;
constexpr size_t WS_LSE = 288 * MiB;
constexpr size_t WS_O = 438 * MiB;
constexpr size_t WS_Z2 = 294 * MiB;
constexpr size_t DO_PQ = 0, DO_PK = 24 * MiB, DO_VT = 48 * MiB, DO_YY = 0;

struct Params {
    const float* in[32];
    float* out;
    unsigned char* ws;
    int ph_lo, ph_hi;
};

__device__ __forceinline__ bf16_t f2bf(float f) { unsigned u = __float_as_uint(f); u += 0x7FFFu + ((u >> 16) & 1u); return (bf16_t)(u >> 16); }
__device__ __forceinline__ float bf2f(bf16_t b) { return __uint_as_float(((unsigned)b) << 16); }
__device__ __forceinline__ unsigned cvt_pk_bf16(float lo, float hi) { unsigned r; asm("v_cvt_pk_bf16_f32 %0, %1, %2" : "=v"(r) : "v"(lo), "v"(hi)); return r; }
__device__ __forceinline__ float bflo(unsigned w) { return __uint_as_float(w << 16); }
__device__ __forceinline__ float bfhi(unsigned w) { return __uint_as_float(w & 0xffff0000u); }
template <int CTRL> __device__ __forceinline__ float dppf(float x) { return __builtin_bit_cast(float, __builtin_amdgcn_update_dpp(0, __builtin_bit_cast(int, x), CTRL, 0xf, 0xf, false)); }
__device__ __forceinline__ int tidx() { int t = threadIdx.x; asm volatile("" : "+v"(t)); return t; }
__device__ __forceinline__ float red16(float x) {
    x += dppf<0xB1>(x); x += dppf<0x4E>(x); x += dppf<0x141>(x); x += dppf<0x128>(x); return x;
}
__device__ __forceinline__ float wave_sum(float x) {
#pragma unroll
    for (int o = 32; o >= 1; o >>= 1) x += __shfl_xor(x, o);
    return x;
}

namespace pg8 {
constexpr int BM = 256, BK = 64, HALF = 128, HTB = HALF * BK * 2, STAGE_BYTES = 8 * HTB, NXCD = 8, WGM = 8;
__device__ __forceinline__ int lds_byte(int r, int c) { const int st = (r >> 4) * 2 + (c >> 5), rr = r & 15, cc = c & 31, ob = rr * 64 + cc * 2; return st * 1024 + (ob ^ (((ob >> 9) & 1) << 5)); }
__device__ __forceinline__ void stage_rc(int b, int& R, int& C) { const int st = b / 1024, sb = b % 1024, swz = sb ^ (((sb >> 9) & 1) << 5); R = (st >> 1) * 16 + swz / 64; C = (st & 1) * 32 + (swz % 64) / 2; }
__device__ __forceinline__ int perm32(int rho) { const int n = rho >> 4, i = rho & 15; return 8 * (i >> 2) + 4 * n + (i & 3); }
struct Unit { int pm, pn; };
struct Gemm { const bf16_t* A; const bf16_t* Bt; int M, N, K, lda, ldb; };
struct StaticOrder {
    int nM, nN, nwg, G, c;
    __device__ void init(int M, int N, int G_, int c_) { nM = M / BM; nN = N / BM; nwg = nM * nN; G = G_; c = c_; }
    __device__ bool next(int i, Unit& u) const {
        const long L = (long)i * G + c; if (L >= nwg) return false;
        int wgid = (int)L; { const int q = nwg / NXCD, r = nwg % NXCD, xcd = wgid % NXCD, off = wgid / NXCD; wgid = (xcd < r ? xcd * (q + 1) : r * (q + 1) + (xcd - r) * q) + off; }
        const int nig = WGM * nN, gid = wgid / nig, fm = gid * WGM, gsz = (nM - fm) < WGM ? (nM - fm) : WGM;
        u.pm = fm + ((wgid % nig) % gsz); u.pn = (wgid % nig) / gsz; return true;
    }
};

template <class Epi>
__device__ __forceinline__ void gemm_phase(LAS unsigned char* lds, const Gemm g, const StaticOrder& S, const Epi& E) {
    const int tid = tidx(), wid = __builtin_amdgcn_readfirstlane(tid >> 6), lane = tid & 63, wr = wid >> 2, wc = wid & 3, fr = lane & 15, fq = lane >> 4;
    int K = g.K, lda_ = g.lda, ldb_ = g.ldb; asm volatile("" : "+s"(K), "+s"(lda_), "+s"(ldb_));
    const int nt = K / BK;
    unsigned voffA[2], voffB[2];
#pragma unroll
    for (int i = 0; i < 2; ++i) { int R, C; stage_rc(tid * 16 + i * 8192, R, C); const int Rb = Epi::PERM ? ((R & ~31) + perm32(R & 31)) : R;
        voffA[i] = (unsigned)(R * lda_ + C) * 2u; voffB[i] = (unsigned)(Rb * ldb_ + C) * 2u; }
    const size_t kstep = (size_t)(BK * 2);
    const size_t hstepA = (size_t)HALF * lda_ * 2, hstepB = (size_t)HALF * ldb_ * 2;
    const size_t tstepA = 2 * hstepA, tstepB = 2 * hstepB;
    const unsigned ldsw = (unsigned)wid * 1024u;
    const int aoff = lds_byte(wr * 64 + fr, fq * 8), boff = lds_byte(wc * 32 + fr, fq * 8);
#define PG8_SA(b, h) (((b) * 2 + (h)) * HTB)
#define PG8_SB(b, h) ((4 + (b) * 2 + (h)) * HTB)
#define PG8_STAGE(bufoff, gbase, voff) do { _Pragma("unroll") for (int _i = 0; _i < 2; ++_i) \
        __builtin_amdgcn_global_load_lds((const unsigned*)((const char*)(gbase) + (voff)[_i]), (LAS unsigned*)(lds + (bufoff) + ldsw + _i * 8192), 16, 0, 0); } while (0)
#define PG8_LDA(dst, b, h) do { _Pragma("unroll") for (int m = 0; m < 4; ++m) _Pragma("unroll") for (int k = 0; k < 2; ++k) dst[m][k] = *(const LAS bf16x8*)(lds + PG8_SA(b, h) + aoff + m * 2048 + k * 1024); } while (0)
#define PG8_LDB(dst, b, h) do { _Pragma("unroll") for (int n = 0; n < 2; ++n) _Pragma("unroll") for (int k = 0; k < 2; ++k) dst[n][k] = *(const LAS bf16x8*)(lds + PG8_SB(b, h) + boff + n * 2048 + k * 1024); } while (0)
#define PG8_MMA(ai, bj, At, Bt) do { __builtin_amdgcn_s_setprio(1); _Pragma("unroll") for (int m = 0; m < 4; ++m) _Pragma("unroll") for (int n = 0; n < 2; ++n) _Pragma("unroll") for (int k = 0; k < 2; ++k) \
        acc[ai][bj][m][n] = __builtin_amdgcn_mfma_f32_16x16x32_bf16(Bt[n][k], At[m][k], acc[ai][bj][m][n], 0, 0, 0); __builtin_amdgcn_s_setprio(0); } while (0)
#define PG8_WAIT_V(n) asm volatile("s_waitcnt vmcnt(" #n ")" ::: "memory")
#define PG8_WAIT_L(n) asm volatile("s_waitcnt lgkmcnt(" #n ")" ::: "memory")
#define PG8_BAR __builtin_amdgcn_s_barrier()
#define PG8_SCHED __builtin_amdgcn_sched_barrier(0)
    Unit cur, nxt; int ui = 0;
    if (!S.next(0, cur)) return;
    f32x4 acc[2][2][4][2];
#pragma unroll
    for (int a = 0; a < 2; ++a)
#pragma unroll
        for (int b = 0; b < 2; ++b)
#pragma unroll
            for (int m = 0; m < 4; ++m)
#pragma unroll
                for (int n = 0; n < 2; ++n) acc[a][b][m][n] = (f32x4){0.f, 0.f, 0.f, 0.f};
    bf16x8 At[4][2], B0[2][2], B1[2][2];
    const char* cA = (const char*)g.A + (size_t)cur.pm * tstepA; const char* cB = (const char*)g.Bt + (size_t)cur.pn * tstepB;
    PG8_STAGE(PG8_SB(0, 0), cB, voffB); PG8_STAGE(PG8_SA(0, 0), cA, voffA); PG8_STAGE(PG8_SB(0, 1), cB + hstepB, voffB); PG8_STAGE(PG8_SA(0, 1), cA + hstepA, voffA);
    if (wr == 1) PG8_BAR;
    PG8_WAIT_V(4); PG8_BAR;
    PG8_STAGE(PG8_SB(1, 0), cB + kstep, voffB); PG8_STAGE(PG8_SA(1, 0), cA + kstep, voffA); PG8_STAGE(PG8_SB(1, 1), cB + hstepB + kstep, voffB);
    PG8_WAIT_V(6); PG8_BAR;
    for (;;) {
        const bool has_next = S.next(ui + 1, nxt);
        const char* nA = has_next ? (const char*)g.A + (size_t)nxt.pm * tstepA : cA; const char* nB = has_next ? (const char*)g.Bt + (size_t)nxt.pn * tstepB : cB;
        for (int t = 0; t < nt; t += 2) {
            const bool last = (t == nt - 2);
            const char* a1 = cA + (size_t)(t + 1) * kstep;
            const char* a2 = last ? nA : cA + (size_t)(t + 2) * kstep; const char* b2 = last ? nB : cB + (size_t)(t + 2) * kstep;
            const char* a3 = a2 + kstep; const char* b3 = b2 + kstep;
            PG8_LDB(B0, 0, 0); PG8_SCHED; PG8_LDA(At, 0, 0); PG8_STAGE(PG8_SA(1, 1), a1 + hstepA, voffA);
            PG8_WAIT_L(8); PG8_BAR; PG8_WAIT_L(0); PG8_MMA(0, 0, At, B0); PG8_BAR; PG8_SCHED;
            PG8_LDB(B1, 0, 1); PG8_STAGE(PG8_SB(0, 0), b2, voffB);
            PG8_BAR; PG8_WAIT_L(0); PG8_MMA(0, 1, At, B1); PG8_BAR;
            PG8_LDA(At, 0, 1); PG8_STAGE(PG8_SA(0, 0), a2, voffA);
            PG8_BAR; PG8_WAIT_L(0); PG8_MMA(1, 0, At, B0); PG8_BAR; PG8_SCHED;
            PG8_STAGE(PG8_SB(0, 1), b2 + hstepB, voffB);
            PG8_WAIT_V(6); PG8_BAR; PG8_MMA(1, 1, At, B1); PG8_BAR;
            PG8_LDB(B0, 1, 0); PG8_SCHED; PG8_LDA(At, 1, 0); PG8_STAGE(PG8_SA(0, 1), a2 + hstepA, voffA);
            PG8_WAIT_L(8); PG8_BAR; PG8_WAIT_L(0); PG8_MMA(0, 0, At, B0); PG8_BAR; PG8_SCHED;
            PG8_LDB(B1, 1, 1); PG8_STAGE(PG8_SB(1, 0), b3, voffB);
            PG8_BAR; PG8_WAIT_L(0); PG8_MMA(0, 1, At, B1); PG8_BAR;
            PG8_LDA(At, 1, 1); PG8_STAGE(PG8_SA(1, 0), a3, voffA);
            PG8_BAR; PG8_WAIT_L(0); PG8_MMA(1, 0, At, B0); PG8_BAR; PG8_SCHED;
            PG8_STAGE(PG8_SB(1, 1), b3 + hstepB, voffB);
            PG8_WAIT_V(6); PG8_BAR; PG8_MMA(1, 1, At, B1); PG8_BAR;
        }
        E(acc, cur, wr, wc, fr, fq);
        if (!has_next) break;
#pragma unroll
        for (int a = 0; a < 2; ++a)
#pragma unroll
            for (int b = 0; b < 2; ++b)
#pragma unroll
                for (int m = 0; m < 4; ++m)
#pragma unroll
                    for (int n = 0; n < 2; ++n) acc[a][b][m][n] = (f32x4){0.f, 0.f, 0.f, 0.f};
        cur = nxt; cA = nA; cB = nB; ++ui;
    }
    PG8_WAIT_V(0);
    if (wr == 0) PG8_BAR;
    PG8_BAR;
#undef PG8_SA
#undef PG8_SB
#undef PG8_STAGE
#undef PG8_LDA
#undef PG8_LDB
#undef PG8_MMA
#undef PG8_WAIT_V
#undef PG8_WAIT_L
#undef PG8_BAR
#undef PG8_SCHED
}
}

typedef f32x4 AccT[2][2][4][2];

__device__ __forceinline__ float silu_f(float x) { return x * __builtin_amdgcn_rcpf(1.0f + __expf(-x)); }

struct EpiSwiGLU {
    static constexpr bool PERM = true;
    bf16_t* H; int ldc;
    __device__ __forceinline__ void operator()(const AccT& acc, const pg8::Unit& u, int wr, int wc, int fr, int fq) const {
        asm volatile("" : "+v"(fr), "+v"(fq));
        const int row0 = u.pm * 256 + wr * 64 + fr, col0 = u.pn * 128 + wc * 32 + 8 * fq;
#pragma unroll
        for (int ai = 0; ai < 2; ++ai)
#pragma unroll
            for (int m = 0; m < 4; ++m) {
                bf16_t* rowp = H + (size_t)(row0 + ai * 128 + m * 16) * ldc + col0;
                const f32x4 g0 = acc[ai][0][m][0], g1 = acc[ai][0][m][1], u0 = acc[ai][1][m][0], u1 = acc[ai][1][m][1];
                u32x4 w;
                w.x = cvt_pk_bf16(silu_f(g0[0]) * u0[0], silu_f(g0[1]) * u0[1]); w.y = cvt_pk_bf16(silu_f(g0[2]) * u0[2], silu_f(g0[3]) * u0[3]);
                w.z = cvt_pk_bf16(silu_f(g1[0]) * u1[0], silu_f(g1[1]) * u1[1]); w.w = cvt_pk_bf16(silu_f(g1[2]) * u1[2], silu_f(g1[3]) * u1[3]);
                *(u32x4*)rowp = w;
            }
    }
};
struct EpiRes {
    static constexpr bool PERM = false;
    float* Z; const float* res; int ldc; float alpha, scale;
    __device__ __forceinline__ void operator()(const AccT& acc, const pg8::Unit& u, int wr, int wc, int fr, int fq) const {
        asm volatile("" : "+v"(fr), "+v"(fq));
        const int row0 = u.pm * 256 + wr * 64 + fr, col0 = u.pn * 256 + wc * 32 + 4 * fq;
#pragma unroll
        for (int ai = 0; ai < 2; ++ai)
#pragma unroll
            for (int m = 0; m < 4; ++m) {
                const size_t off = (size_t)(row0 + ai * 128 + m * 16) * ldc + col0;
#pragma unroll
                for (int bj = 0; bj < 2; ++bj)
#pragma unroll
                    for (int n = 0; n < 2; ++n) {
                        const f32x4 r = *(const f32x4*)(res + off + bj * 128 + n * 16);
                        *(f32x4*)(Z + off + bj * 128 + n * 16) = r * alpha + acc[ai][bj][m][n] * scale;
                    }
            }
    }
};
struct EpiWin {
    static constexpr bool PERM = true;
    unsigned char* ws; long delta;
    __device__ __forceinline__ void operator()(const AccT& acc, const pg8::Unit& u, int wr, int wc, int fr, int fq) const {
        asm volatile("" : "+v"(fr), "+v"(fq));
        const int row0 = u.pm * 256 + wr * 64 + fr, cl = wc * 32 + 8 * fq;
        if (u.pn == 15 || u.pn == 16) {
            const int colt = (u.pn - 15) * 256 + cl;
            float* Plora = (float*)(ws + WS_PLORA);
#pragma unroll
            for (int ai = 0; ai < 2; ++ai)
#pragma unroll
                for (int m = 0; m < 4; ++m) {
                    float* rowp = Plora + (size_t)(row0 + ai * 128 + m * 16) * 512 + colt;
#pragma unroll
                    for (int bj = 0; bj < 2; ++bj)
#pragma unroll
                        for (int n = 0; n < 2; ++n) *(f32x4*)(rowp + bj * 128 + n * 4) = acc[ai][bj][m][n];
                }
        } else {
            size_t boff; int ldc, colt; bool inws = true;
            if (u.pn < 15) { boff = WS_PRKV; ldc = 3840; colt = u.pn * 256; }
            else { const int t = (u.pn - 17) / 3; inws = (t == 2); boff = (t == 0) ? DO_PQ : (t == 1 ? DO_PK : WS_PV); ldc = 768; colt = ((u.pn - 17) % 3) * 256; }
            bf16_t* base = (bf16_t*)(ws + (long)boff + (inws ? 0l : delta));
#pragma unroll
            for (int ai = 0; ai < 2; ++ai)
#pragma unroll
                for (int m = 0; m < 4; ++m) {
                    bf16_t* rowp = base + (size_t)(row0 + ai * 128 + m * 16) * ldc + colt + cl;
#pragma unroll
                    for (int bj = 0; bj < 2; ++bj) {
                        const f32x4 v0 = acc[ai][bj][m][0], v1 = acc[ai][bj][m][1];
                        u32x4 w; w.x = cvt_pk_bf16(v0[0], v0[1]); w.y = cvt_pk_bf16(v0[2], v0[3]); w.z = cvt_pk_bf16(v1[0], v1[1]); w.w = cvt_pk_bf16(v1[2], v1[3]);
                        *(u32x4*)(rowp + bj * 128) = w;
                    }
                }
        }
    }
};
__device__ __forceinline__ int map_row(int n, int mode) {
    if (mode == 1) return (n >> 7) * 256 + (n & 127);
    if (mode == 2) return (n >> 7) * 256 + 128 + (n & 127);
    if (mode == 3) return n < 4288 ? n : n + 64;
    return n;
}
__device__ void convert_weight(const float* __restrict__ W, int K, int N, bf16_t* __restrict__ Wt, int ldk, int mode, float* tile, int bid, int G) {
    const int tid = tidx(), kr = tid >> 4, nc = (tid & 15) * 4, kp = tid & 31, nr = tid >> 5;
    const int tn_n = N / 64, tn_k = K / 64, ntile = tn_n * tn_k;
    int t = bid; if (t >= ntile) return;
    f32x4 v0, v1;
    { const int tk = t / tn_n, tn = t % tn_n; const float* src = W + (size_t)(tk * 64 + kr) * N + tn * 64 + nc; v0 = *(const f32x4*)src; v1 = *(const f32x4*)(src + (size_t)32 * N); }
    while (t < ntile) {
        const int tk = t / tn_n, tn = t % tn_n, tnext = t + G;
        const f32x4 c0 = v0, c1 = v1;
        if (tnext < ntile) { const int tk2 = tnext / tn_n, tn2 = tnext % tn_n; const float* src = W + (size_t)(tk2 * 64 + kr) * N + tn2 * 64 + nc; v0 = *(const f32x4*)src; v1 = *(const f32x4*)(src + (size_t)32 * N); }
#pragma unroll
        for (int j = 0; j < 4; ++j) { tile[kr * 65 + nc + j] = c0[j]; tile[(32 + kr) * 65 + nc + j] = c1[j]; }
        __syncthreads();
        const int drow0 = map_row(tn * 64, mode);
#pragma unroll
        for (int i = 0; i < 4; ++i) { const int n = nr + 16 * i; const float a = tile[(2 * kp) * 65 + n], bq = tile[(2 * kp + 1) * 65 + n];
            *(unsigned*)(Wt + (size_t)(drow0 + n) * ldk + tk * 64 + 2 * kp) = cvt_pk_bf16(a, bq); }
        __syncthreads();
        t = tnext;
    }
}
__device__ void convert_ffn_weights(const Params& p, int ig, int iu, int idn, float* tile, int bid, int G) {
    bf16_t* Wgu = (bf16_t*)(p.ws + WS_WGU); bf16_t* Wd = (bf16_t*)(p.ws + WS_WD);
    convert_weight(p.in[ig], D_, FF_, Wgu, D_, 1, tile, bid, G);
    convert_weight(p.in[iu], D_, FF_, Wgu, D_, 2, tile, (bid + 85) % G, G);
    convert_weight(p.in[idn], FF_, D_, Wd, FF_, 0, tile, (bid + 170) % G, G);
}

__device__ void ln_phase(const float* __restrict__ Z, const float* __restrict__ gam, const float* __restrict__ bet, float* outf, bf16_t* outb, int bid, int G) {
    const int tid = tidx(), wave = tid >> 6, lane = tid & 63;
    f32x4 gv[8], bv[8];
#pragma unroll
    for (int i = 0; i < 8; ++i) { gv[i] = *(const f32x4*)(gam + i * 256 + lane * 4); bv[i] = *(const f32x4*)(bet + i * 256 + lane * 4); }
    for (int row = bid * 8 + wave; row < M_; row += G * 8) {
        const float* zr = Z + (size_t)row * D_;
        f32x4 x[8]; float s = 0.f;
#pragma unroll
        for (int i = 0; i < 8; ++i) { x[i] = *(const f32x4*)(zr + i * 256 + lane * 4); s += (x[i][0] + x[i][1]) + (x[i][2] + x[i][3]); }
        s = wave_sum(s); const float mean = s * (1.0f / D_);
        float q = 0.f;
#pragma unroll
        for (int i = 0; i < 8; ++i) { x[i] = x[i] - mean; q += (x[i][0] * x[i][0] + x[i][1] * x[i][1]) + (x[i][2] * x[i][2] + x[i][3] * x[i][3]); }
        q = wave_sum(q); const float rstd = 1.0f / sqrtf(q * (1.0f / D_) + LN_EPS_);
#pragma unroll
        for (int i = 0; i < 8; ++i) {
            const f32x4 o = x[i] * rstd * gv[i] + bv[i];
            if (outf) *(f32x4*)(outf + (size_t)row * D_ + i * 256 + lane * 4) = o;
            if (outb) { u32x2 w; w.x = cvt_pk_bf16(o[0], o[1]); w.y = cvt_pk_bf16(o[2], o[3]); *(u32x2*)(outb + (size_t)row * D_ + i * 256 + lane * 4) = w; }
        }
    }
}

__device__ void phase_convert0(const Params& p, unsigned char* lds, int bid, int G) {
    float* tile = (float*)lds;
    const int tid = tidx();
    convert_ffn_weights(p, 2, 3, 4, tile, bid, G);
    convert_weight(p.in[7], D_, 6592, (bf16_t*)(p.ws + WS_WIN), D_, 3, tile, bid, G);
    convert_weight(p.in[24], D_, D_, (bf16_t*)(p.ws + WS_WOUT), LDY_, 0, tile, (bid + 128) % G, G);
    { unsigned* z = (unsigned*)((bf16_t*)(p.ws + WS_WIN) + (size_t)4288 * D_); for (int i = bid * 512 + tid; i < 64 * D_ / 2; i += G * 512) z[i] = 0u; }
    { const f32x4* x4 = (const f32x4*)p.in[0]; u32x2* o = (u32x2*)(p.ws + WS_XB);
      for (int i = bid * 512 + tid; i < M_ * D_ / 4; i += G * 512) { const f32x4 v = x4[i]; u32x2 w; w.x = cvt_pk_bf16(v[0], v[1]); w.y = cvt_pk_bf16(v[2], v[3]); o[i] = w; } }
}

__device__ void phase_prep(const Params& p, unsigned char* lds, int bid, int G) {
    const int tid = tidx();
    {
        bf16_t* WL = (bf16_t*)(p.ws + WS_WLORA);
        const float* s0 = p.in[15]; const float* s1 = p.in[17]; const float* s2 = p.in[18];
        for (int i = bid * 512 + tid; i < 1280 * 256; i += G * 512) {
            const int n = i >> 8, k = i & 255;
            WL[i] = (k < 96) ? f2bf(s0[(size_t)k * 1280 + n]) : (bf16_t)0;
            WL[1280 * 256 + i] = (k < 96) ? f2bf(s1[(size_t)k * 1280 + n]) : (bf16_t)0;
            WL[2 * 1280 * 256 + i] = f2bf(s2[(size_t)k * 1280 + n]);
        }
    }
    {
        const float* PL = (const float*)(p.ws + WS_PLORA); bf16_t* XL = (bf16_t*)(p.ws + WS_XLORA);
        const float* mu_w = p.in[11]; const float* mu_a = p.in[12]; const float* mu_g = p.in[13];
        for (int i = bid * 512 + tid; i < M_ * 768; i += G * 512) {
            const int t = i / 768, c = i % 768; float o = 0.f;
            int src = -1; float mu = 0.f; int kind = 0;
            if (c < 96) { src = c; mu = mu_w[c]; kind = 0; }
            else if (c >= 256 && c < 352) { src = 96 + (c - 256); mu = mu_a[c - 256]; kind = 1; }
            else if (c >= 512) { src = 192 + (c - 512); mu = mu_g[c - 512]; kind = 2; }
            if (src >= 0) {
                const float z = PL[(size_t)t * 512 + src]; const float zp = (t % T_) ? PL[(size_t)(t - 1) * 512 + src] : 0.f;
                const float s = z + (zp - z) * mu;
                o = (kind == 0) ? tanhf(s) : (kind == 1 ? s : 1.0f / (1.0f + expf(-s)));
            }
            XL[i] = f2bf(o);
        }
    }
    {
        bf16_t* Pq = (bf16_t*)((unsigned char*)p.out + DO_PQ); bf16_t* Pk = (bf16_t*)((unsigned char*)p.out + DO_PK);
        const int* pos = (const int*)p.in[1];
        for (int i = bid * 512 + tid; i < M_ * 2 * NHA_ * 8; i += G * 512) {
            const int j = i & 7, hh = (i >> 3) % NHA_, qk = (i / (8 * NHA_)) & 1, t = i / (16 * NHA_);
            bf16_t* P = (qk ? Pk : Pq) + (size_t)t * AD_ + hh * 64;
            const float invf = exp2f(-(float)j * 2.3664460711655217f);
            const float ang = (float)pos[t] * invf; const double rv = (double)ang * 0.15915494309189535; const float rev = (float)(rv - rint(rv));
            const float sn = __builtin_amdgcn_sinf(rev), cs = __builtin_amdgcn_cosf(rev);
            const float x1 = bf2f(P[j]), x2 = bf2f(P[8 + j]);
            P[j] = f2bf(x1 * cs - x2 * sn); P[8 + j] = f2bf(x2 * cs + x1 * sn);
        }
    }
    {
        const bf16_t* Pv = (const bf16_t*)(p.ws + WS_PV); bf16_t* VT = (bf16_t*)((unsigned char*)p.out + DO_VT);
        bf16_t* tl = (bf16_t*)lds;
        for (int job = bid; job < (M_ / 256) * NHA_; job += G) {
            const int hh = job % NHA_, tb = job / NHA_, tok0 = tb * 256, b = tok0 / T_, t0 = tok0 % T_;
            __syncthreads();
            for (int i = tid; i < 256 * 32; i += 512) { const int tr = i >> 5, cp = i & 31; *(unsigned*)(tl + tr * 66 + cp * 2) = *(const unsigned*)(Pv + (size_t)(tok0 + tr) * AD_ + hh * 64 + cp * 2); }
            __syncthreads();
#pragma unroll
            for (int g = 0; g < 3; ++g) {
                const int sh = 2 * g, d = 1 << sh, per = 256 >> sh;
                bf16_t* dst = VT + (size_t)g * M_ * AD_ + ((size_t)(b * NHA_ + hh) * 64) * T_;
                for (int o = tid; o < 64 * 256; o += 512) {
                    const int e = o >> 8, j = o & 255, r = j / per, q = j % per, tloc = q * d + r;
                    dst[(size_t)e * T_ + r * (T_ >> sh) + (t0 >> sh) + q] = tl[tloc * 66 + e];
                }
            }
        }
        __syncthreads();
    }
}

__device__ __forceinline__ float lora_act(int which, float x, float c) {
    if (which == 0) { const float z = -(c + x); const float sp = fmaxf(z, 0.f) + __logf(1.0f + __expf(-fabsf(z))); return __expf(-sp - 0.5f); }
    if (which == 1) return __builtin_amdgcn_rcpf(1.0f + __expf(-(c + x)));
    return x;
}
__device__ void lora_phase(const Params& p, unsigned char* lds, int wlo, int whi, int bid, int G) {
    const int tid = tidx(), wave = tid >> 6, lane = tid & 63, rl = lane & 15, gq = lane >> 4;
    const bf16_t* XL = (const bf16_t*)(p.ws + WS_XLORA); const bf16_t* WL = (const bf16_t*)(p.ws + WS_WLORA);
    unsigned char* Ash = lds;
    unsigned char* Bsh = lds + 128 * 528;
    asm volatile("" : "+s"(wlo), "+s"(whi));
    const int nw = whi - wlo, nitem = 128 * nw * 2;
    for (int item = bid; item < nitem; item += G) {
        const int half = item & 1, which = wlo + (item >> 1) % nw, rb = (item >> 1) / nw;
        const int K = (which == 2) ? 256 : 128, koff = which * 256, cpr = K / 8;
        bf16_t* Ob = (bf16_t*)(p.ws + (which == 0 ? WS_LW : (which == 1 ? WS_LA : WS_LG)));
        const float* cvec = (which == 0) ? p.in[14] : p.in[16];
        __syncthreads();
        for (int c = tid; c < 128 * cpr; c += 512) { const int r = c / cpr, ck = c % cpr; *(u32x4*)(Ash + r * 528 + ck * 16) = *(const u32x4*)(XL + (size_t)(rb * 128 + r) * 768 + koff + ck * 8); }
        for (int cb = 0; cb < 10; ++cb) {
            const int col0 = (half * 10 + cb) * 64;
            __syncthreads();
            for (int c = tid; c < 64 * cpr; c += 512) { const int r = c / cpr, ck = c % cpr; *(u32x4*)(Bsh + r * 528 + ck * 16) = *(const u32x4*)(WL + (size_t)which * 1280 * 256 + (size_t)(col0 + r) * 256 + ck * 8); }
            __syncthreads();
            f32x4 acc[4];
#pragma unroll
            for (int nt = 0; nt < 4; ++nt) acc[nt] = (f32x4){0.f, 0.f, 0.f, 0.f};
            for (int ks = 0; ks < K / 32; ++ks) {
                const bf16x8 Af = *(const bf16x8*)(Ash + (16 * wave + rl) * 528 + ks * 64 + gq * 16);
#pragma unroll
                for (int nt = 0; nt < 4; ++nt) { const bf16x8 Bf = *(const bf16x8*)(Bsh + (16 * nt + rl) * 528 + ks * 64 + gq * 16); acc[nt] = __builtin_amdgcn_mfma_f32_16x16x32_bf16(Bf, Af, acc[nt], 0, 0, 0); }
            }
            const size_t row = (size_t)rb * 128 + 16 * wave + rl;
#pragma unroll
            for (int nt = 0; nt < 4; ++nt) {
                const int col = col0 + 16 * nt + 4 * gq; f32x4 cv = {0.f, 0.f, 0.f, 0.f};
                if (which != 2) cv = *(const f32x4*)(cvec + col);
                u32x2 w; w.x = cvt_pk_bf16(lora_act(which, acc[nt][0], cv[0]), lora_act(which, acc[nt][1], cv[1])); w.y = cvt_pk_bf16(lora_act(which, acc[nt][2], cv[2]), lora_act(which, acc[nt][3], cv[3]));
                *(u32x2*)(Ob + row * RW_ + col) = w;
            }
        }
    }
    __syncthreads();
}

__device__ void scan_unit(const Params& p, unsigned char* lds, int bh, int qd) {
    const int tid = tidx(), wave = tid >> 6, lane = tid & 63;
    const int b = bh / NHR_, h = bh % NHR_;
    float* bufX = (float*)lds;
    float* bufV = (float*)(lds + 81920);
    float* bufY = (float*)(lds + 81920 + 4096);
    const bf16_t* Prkv = (const bf16_t*)(p.ws + WS_PRKV); const bf16_t* Lw = (const bf16_t*)(p.ws + WS_LW); const bf16_t* La = (const bf16_t*)(p.ws + WS_LA);
    bf16_t* Y = (bf16_t*)(p.ws + WS_Y);
    const bool loader = wave >= 4;
    const int ts = lane >> 4, cg = lane & 15, ch = h * 64 + cg * 4;
    f32x4 mu_r = {0, 0, 0, 0}, mu_k = mu_r, mu_v = mu_r, k_k = mu_r, k_a = mu_r;
    if (loader) { mu_r = *(const f32x4*)(p.in[8] + ch); mu_k = *(const f32x4*)(p.in[9] + ch); mu_v = *(const f32x4*)(p.in[10] + ch); k_k = *(const f32x4*)(p.in[19] + ch); k_a = *(const f32x4*)(p.in[20] + ch); }
    const int lw = wave - 4;
    f32x4 S = {0.f, 0.f, 0.f, 0.f};
    const int rowl = 4 * (wave & 3) + (lane >> 4);

    struct LReg { u32x2 rr, kr, vr, rp, kp, vp, ew, av; };
#define SC_ISSUE(cc, R, gi) { const int tl_ = 4 * (lw + 4 * (gi)) + ts, tseq_ = (cc) * 32 + tl_; const size_t tok_ = (size_t)b * T_ + tseq_; const bf16_t* pr_ = Prkv + tok_ * 3840 + ch; \
        R.rr = *(const u32x2*)pr_; R.kr = *(const u32x2*)(pr_ + 1280); R.vr = *(const u32x2*)(pr_ + 2560); \
        R.rp = (u32x2){0u, 0u}; R.kp = R.rp; R.vp = R.rp; \
        if (tseq_ > 0) { R.rp = *(const u32x2*)(pr_ - 3840); R.kp = *(const u32x2*)(pr_ - 3840 + 1280); R.vp = *(const u32x2*)(pr_ - 3840 + 2560); } \
        R.ew = *(const u32x2*)(Lw + tok_ * 1280 + ch); R.av = *(const u32x2*)(La + tok_ * 1280 + ch); }
#define SC_PROC(buf_, R, gi) { const int tl_ = 4 * (lw + 4 * (gi)) + ts; \
        const f32x4 r0 = {bflo(R.rr.x), bfhi(R.rr.x), bflo(R.rr.y), bfhi(R.rr.y)}, r1 = {bflo(R.rp.x), bfhi(R.rp.x), bflo(R.rp.y), bfhi(R.rp.y)}; \
        const f32x4 k0 = {bflo(R.kr.x), bfhi(R.kr.x), bflo(R.kr.y), bfhi(R.kr.y)}, k1 = {bflo(R.kp.x), bfhi(R.kp.x), bflo(R.kp.y), bfhi(R.kp.y)}; \
        const f32x4 v0 = {bflo(R.vr.x), bfhi(R.vr.x), bflo(R.vr.y), bfhi(R.vr.y)}, v1 = {bflo(R.vp.x), bfhi(R.vp.x), bflo(R.vp.y), bfhi(R.vp.y)}; \
        const f32x4 ew = {bflo(R.ew.x), bfhi(R.ew.x), bflo(R.ew.y), bfhi(R.ew.y)}, av = {bflo(R.av.x), bfhi(R.av.x), bflo(R.av.y), bfhi(R.av.y)}; \
        const f32x4 r = r0 + (r1 - r0) * mu_r, k = k0 + (k1 - k0) * mu_k, v = v0 + (v1 - v0) * mu_v; \
        f32x4 dec; dec[0] = __builtin_amdgcn_exp2f(ew[0] * -1.4426950408889634f); dec[1] = __builtin_amdgcn_exp2f(ew[1] * -1.4426950408889634f); dec[2] = __builtin_amdgcn_exp2f(ew[2] * -1.4426950408889634f); dec[3] = __builtin_amdgcn_exp2f(ew[3] * -1.4426950408889634f); \
        const f32x4 kku = k * k_k; float s1 = (kku[0] * kku[0] + kku[1] * kku[1]) + (kku[2] * kku[2] + kku[3] * kku[3]); s1 = red16(s1); \
        const float rn = 1.0f / fmaxf(sqrtf(s1), 1e-12f); const f32x4 kk = kku * rn; const f32x4 k2 = k * (1.0f + (av - 1.0f) * k_a); \
        float* X = bufX + ((size_t)((buf_) * 32 + tl_)) * 320 + cg * 4; \
        *(f32x4*)(X) = dec; *(f32x4*)(X + 64) = -kk; *(f32x4*)(X + 128) = kk * av; *(f32x4*)(X + 192) = k2; *(f32x4*)(X + 256) = r; \
        if ((cg >> 2) == qd) *(f32x4*)(bufV + ((buf_) * 32 + tl_) * 16 + (cg & 3) * 4) = v; }
    LReg A0, A1, B0, B1;
    auto store_y = [&](int c, int buf) {
        const int lt = tid - 256, tl = lt >> 3, pr = lt & 7;
        const float y0 = bufY[(buf * 32 + tl) * 16 + 2 * pr], y1 = bufY[(buf * 32 + tl) * 16 + 2 * pr + 1];
        *(unsigned*)(Y + ((size_t)b * T_ + c * 32 + tl) * 1280 + h * 64 + 16 * qd + 2 * pr) = cvt_pk_bf16(y0, y1);
    };

    __syncthreads();
    if (loader) { SC_ISSUE(0, A0, 0); SC_ISSUE(0, A1, 1); SC_PROC(0, A0, 0); SC_PROC(0, A1, 1); SC_ISSUE(1, A0, 0); SC_ISSUE(1, A1, 1); }
    __syncthreads();
    for (int c = 0; c < T_ / 32; ++c) {
        const int buf = c & 1;
        if (!loader) {
            const float* Xc = bufX + (size_t)(buf * 32) * 320 + cg * 4;
            const float* Vc = bufV + (buf * 32) * 16 + rowl;
#define SC_LD(i, W, A, B, K, R, V) { const float* X_ = Xc + (i) * 320; W = *(const f32x4*)X_; A = *(const f32x4*)(X_ + 64); B = *(const f32x4*)(X_ + 128); K = *(const f32x4*)(X_ + 192); R = *(const f32x4*)(X_ + 256); V = Vc[(i) * 16]; }
#define SC_STEP(tt, W, A, B, K, R, V) { \
                f32x2 pa_ = (f32x2){S[0], S[1]} * (f32x2){A[0], A[1]}; pa_ = __builtin_elementwise_fma((f32x2){S[2], S[3]}, (f32x2){A[2], A[3]}, pa_); float sa = pa_.x + pa_.y; sa = red16(sa); \
                S = S * W + B * sa + K * V; \
                f32x2 py_ = (f32x2){S[0], S[1]} * (f32x2){R[0], R[1]}; py_ = __builtin_elementwise_fma((f32x2){S[2], S[3]}, (f32x2){R[2], R[3]}, py_); float y = py_.x + py_.y; y = red16(y); \
                ykeep = (cg == ((tt) & 15)) ? y : ykeep; \
                if (((tt) & 15) == 15) bufY[(buf * 32 + ((tt) - 15) + cg) * 16 + rowl] = ykeep; }
            f32x4 w0, a0, b0, k0, r0, w1, a1, b1, k1, r1, w2, a2, b2, k2, r2, w3, a3, b3, k3, r3; float v0, v1, v2, v3; float ykeep = 0.f;
            SC_LD(0, w0, a0, b0, k0, r0, v0); SC_LD(1, w1, a1, b1, k1, r1, v1);
#pragma unroll
            for (int t = 0; t < 32; t += 2) {
                SC_LD((t + 2 < 32 ? t + 2 : 31), w2, a2, b2, k2, r2, v2);
                SC_STEP(t, w0, a0, b0, k0, r0, v0);
                SC_LD((t + 3 < 32 ? t + 3 : 31), w3, a3, b3, k3, r3, v3);
                SC_STEP(t + 1, w1, a1, b1, k1, r1, v1);
                w0 = w2; a0 = a2; b0 = b2; k0 = k2; r0 = r2; v0 = v2; w1 = w3; a1 = a3; b1 = b3; k1 = k3; r1 = r3; v1 = v3;
            }
#undef SC_LD
#undef SC_STEP
        } else {
            { const int c2 = (c + 2 < T_ / 32) ? c + 2 : T_ / 32 - 1; SC_ISSUE(c2, B0, 0); SC_ISSUE(c2, B1, 1); }
            if (c + 1 < T_ / 32) { SC_PROC(buf ^ 1, A0, 0); SC_PROC(buf ^ 1, A1, 1); }
            if (c > 0) store_y(c - 1, buf ^ 1);
            A0 = B0; A1 = B1;
        }
        __syncthreads();
    }
    if (loader) store_y(T_ / 32 - 1, 1);
    __syncthreads();
}

__device__ void attn_item(const Params& p, unsigned char* lds, int item) {
    const int tid = tidx(), wave = tid >> 6, lane = tid & 63, qn = lane & 15, gq = lane >> 4;
    const int g = item / 1536, rem = item % 1536, b = rem / 768, hh = (rem >> 6) % NHA_, rn = rem & 63;
    const int sh = 2 * g, d = 1 << sh, L = T_ >> sh, nb = 64 >> sh, r = rn / nb, n = rn % nb;
    const bf16_t* Pq = (const bf16_t*)((unsigned char*)p.out + DO_PQ); const bf16_t* Pk = (const bf16_t*)((unsigned char*)p.out + DO_PK);
    const bf16_t* VT = (const bf16_t*)((unsigned char*)p.out + DO_VT) + (size_t)g * M_ * AD_ + ((size_t)(b * NHA_ + hh) * 64) * T_;
    bf16_t* Og = (bf16_t*)(p.ws + WS_O) + (size_t)g * M_ * AD_; float* lse = (float*)(p.ws + WS_LSE) + (size_t)g * M_ * NHA_;
    unsigned char* Ksh = lds;
    unsigned char* Vsh = lds + 256 * 144;
    __syncthreads();
#pragma unroll
    for (int i = 0; i < 4; ++i) {
        const int chunk = tid + 512 * i, kap = chunk >> 3, part = chunk & 7;
        const int lp = 128 * (n - 1) + kap; u32x4 val = {0u, 0u, 0u, 0u};
        if (lp >= 0) val = *(const u32x4*)(Pk + ((size_t)b * T_ + (size_t)lp * d + r) * AD_ + hh * 64 + part * 8);
        const int row = (kap & 0xE0) | (((kap >> 2) & 1) << 4) | (((kap >> 3) & 3) << 2) | (kap & 3);
        *(u32x4*)(Ksh + row * 144 + part * 16) = val;
    }
#pragma unroll
    for (int i = 0; i < 4; ++i) {
        const int chunk = tid + 512 * i, e = chunk >> 5, part = chunk & 31, k0 = part * 8;
        u32x4 val = {0u, 0u, 0u, 0u};
        if (n > 0 || k0 >= 128) val = *(const u32x4*)(VT + (size_t)e * T_ + r * L + 128 * (n - 1) + k0);
        *(u32x4*)(Vsh + e * 528 + part * 16) = val;
    }
    const int q = 16 * wave + qn; const size_t qtok = (size_t)b * T_ + (size_t)(128 * n + q) * d + r;
    const bf16x8 Q0 = *(const bf16x8*)(Pq + qtok * AD_ + hh * 64 + gq * 8), Q1 = *(const bf16x8*)(Pq + qtok * AD_ + hh * 64 + 32 + gq * 8);
    __syncthreads();
    const int s0 = wave >> 1;
    f32x4 sacc[5][2];
#pragma unroll
    for (int st = 0; st < 5; ++st)
#pragma unroll
        for (int bb = 0; bb < 2; ++bb) {
            const int row = (s0 + st) * 32 + bb * 16 + qn;
            const bf16x8 K0 = *(const bf16x8*)(Ksh + row * 144 + gq * 16), K1 = *(const bf16x8*)(Ksh + row * 144 + 64 + gq * 16);
            f32x4 a = {0.f, 0.f, 0.f, 0.f};
            a = __builtin_amdgcn_mfma_f32_16x16x32_bf16(K0, Q0, a, 0, 0, 0);
            a = __builtin_amdgcn_mfma_f32_16x16x32_bf16(K1, Q1, a, 0, 0, 0);
            sacc[st][bb] = a;
        }
    const float SC = 0.125f * 1.4426950408889634f;
    float mx = -INFINITY;
#pragma unroll
    for (int st = 0; st < 5; ++st)
#pragma unroll
        for (int bb = 0; bb < 2; ++bb)
#pragma unroll
            for (int i = 0; i < 4; ++i) {
                const int kap = 32 * (s0 + st) + 8 * gq + 4 * bb + i, rel = q + 128 - kap;
                const bool valid = (rel >= 0) && (rel <= 128) && (n > 0 || kap >= 128);
                const float sv = valid ? sacc[st][bb][i] * SC : -INFINITY;
                sacc[st][bb][i] = sv; mx = fmaxf(mx, sv);
            }
    mx = fmaxf(mx, __shfl_xor(mx, 16)); mx = fmaxf(mx, __shfl_xor(mx, 32));
    float den = 0.f; bf16x8 Pf[5];
#pragma unroll
    for (int st = 0; st < 5; ++st) {
        float pv[8];
#pragma unroll
        for (int bb = 0; bb < 2; ++bb)
#pragma unroll
            for (int i = 0; i < 4; ++i) { const float pe = __builtin_amdgcn_exp2f(sacc[st][bb][i] - mx); pv[bb * 4 + i] = pe; den += pe; }
        u32x4 w; w.x = cvt_pk_bf16(pv[0], pv[1]); w.y = cvt_pk_bf16(pv[2], pv[3]); w.z = cvt_pk_bf16(pv[4], pv[5]); w.w = cvt_pk_bf16(pv[6], pv[7]);
        Pf[st] = __builtin_bit_cast(bf16x8, w);
    }
    den += __shfl_xor(den, 16); den += __shfl_xor(den, 32);
    f32x4 oacc[4];
#pragma unroll
    for (int et = 0; et < 4; ++et) oacc[et] = (f32x4){0.f, 0.f, 0.f, 0.f};
#pragma unroll
    for (int st = 0; st < 5; ++st)
#pragma unroll
        for (int et = 0; et < 4; ++et) {
            const bf16x8 Vf = *(const bf16x8*)(Vsh + (16 * et + qn) * 528 + ((s0 + st) * 32 + 8 * gq) * 2);
            oacc[et] = __builtin_amdgcn_mfma_f32_16x16x32_bf16(Vf, Pf[st], oacc[et], 0, 0, 0);
        }
    const float inv = 1.0f / den;
#pragma unroll
    for (int et = 0; et < 4; ++et) {
        u32x2 w; w.x = cvt_pk_bf16(oacc[et][0] * inv, oacc[et][1] * inv); w.y = cvt_pk_bf16(oacc[et][2] * inv, oacc[et][3] * inv);
        *(u32x2*)(Og + qtok * AD_ + hh * 64 + 16 * et + 4 * gq) = w;
    }
    if (gq == 0) lse[qtok * NHA_ + hh] = mx * 0.6931471805599453f + logf(den);
}

__device__ void phase_scan_attn(const Params& p, unsigned char* lds, int bid, int G) {
    constexpr int NSCAN = 160, NITEM = 3 * 1536;
    if (G > NSCAN) {
        if (bid < NSCAN) { const int xcd = bid & 7, slot = bid >> 3; scan_unit(p, lds, xcd * 5 + (slot >> 2), slot & 3); }
        else { for (int it = bid - NSCAN; it < NITEM; it += G - NSCAN) attn_item(p, lds, it); }
    } else {
        for (int u = bid; u < NSCAN; u += G) scan_unit(p, lds, u >> 2, u & 3);
        for (int it = bid; it < NITEM; it += G) attn_item(p, lds, it);
    }
    __syncthreads();
}

__device__ void phase_post(const Params& p, int bid, int G) {
    const int tid = tidx(), wave = tid >> 6, lane = tid & 63, cgp = lane & 15;
    const bf16_t* Prkv = (const bf16_t*)(p.ws + WS_PRKV); const bf16_t* La = (const bf16_t*)(p.ws + WS_LA); const bf16_t* Lg = (const bf16_t*)(p.ws + WS_LG);
    const bf16_t* Ys = (const bf16_t*)(p.ws + WS_Y); bf16_t* YY = (bf16_t*)((unsigned char*)p.out + DO_YY);
    {
        const int gw = bid * 8 + wave, nslot = (G * 8) / 5;
        if (gw < nslot * 5) {
            const int hg = gw % 5, ch = hg * 256 + lane * 4;
            const f32x4 mu_r = *(const f32x4*)(p.in[8] + ch), mu_k = *(const f32x4*)(p.in[9] + ch), mu_v = *(const f32x4*)(p.in[10] + ch);
            const f32x4 k_a = *(const f32x4*)(p.in[20] + ch), r_k = *(const f32x4*)(p.in[21] + ch), gng = *(const f32x4*)(p.in[22] + ch), gnb = *(const f32x4*)(p.in[23] + ch);
#define PO_LOAD(t, S) u32x2 S##rr, S##kr, S##vr, S##rp = {0u, 0u}, S##kp = {0u, 0u}, S##vp = {0u, 0u}, S##a2, S##g2, S##y2; { const bf16_t* pr = Prkv + (size_t)(t) * 3840 + ch; \
                S##rr = *(const u32x2*)pr; S##kr = *(const u32x2*)(pr + 1280); S##vr = *(const u32x2*)(pr + 2560); \
                if (((t) % T_) > 0) { S##rp = *(const u32x2*)(pr - 3840); S##kp = *(const u32x2*)(pr - 3840 + 1280); S##vp = *(const u32x2*)(pr - 3840 + 2560); } \
                S##a2 = *(const u32x2*)(La + (size_t)(t) * 1280 + ch); S##g2 = *(const u32x2*)(Lg + (size_t)(t) * 1280 + ch); S##y2 = *(const u32x2*)(Ys + (size_t)(t) * 1280 + ch); }
#define PO_UNP(w) ((f32x4){bflo(w.x), bfhi(w.x), bflo(w.y), bfhi(w.y)})
#define PO_COMP(t, S) { const f32x4 r0 = PO_UNP(S##rr), r1 = PO_UNP(S##rp), k0 = PO_UNP(S##kr), k1 = PO_UNP(S##kp), v0 = PO_UNP(S##vr), v1 = PO_UNP(S##vp), av = PO_UNP(S##a2), gv = PO_UNP(S##g2), yv = PO_UNP(S##y2); \
                const f32x4 r = r0 + (r1 - r0) * mu_r, k = k0 + (k1 - k0) * mu_k, v = v0 + (v1 - v0) * mu_v; \
                const f32x4 k2 = k * (1.0f + (av - 1.0f) * k_a); const f32x4 rk4 = r * k2 * r_k; \
                const float rk = red16((rk4[0] + rk4[1]) + (rk4[2] + rk4[3])); \
                const float mu = red16((yv[0] + yv[1]) + (yv[2] + yv[3])) * (1.0f / 64.0f); const f32x4 yc = yv - mu; \
                const float var = red16((yc[0] * yc[0] + yc[1] * yc[1]) + (yc[2] * yc[2] + yc[3] * yc[3])) * (1.0f / 64.0f); \
                const float rstd = 1.0f / sqrtf(var + GN_EPS_); const f32x4 o = (yc * rstd * gng + gnb + v * rk) * gv; \
                u32x2 w; w.x = cvt_pk_bf16(o[0], o[1]); w.y = cvt_pk_bf16(o[2], o[3]); *(u32x2*)(YY + (size_t)(t) * LDY_ + ch) = w; }
            for (int t = gw / 5; t < M_; t += 2 * nslot) {
                const int tb = t + nslot; const bool hasb = tb < M_; const int tbc = hasb ? tb : t;
                PO_LOAD(t, A_); PO_LOAD(tbc, B_);
                PO_COMP(t, A_);
                if (hasb) PO_COMP(tb, B_);
            }
#undef PO_LOAD
#undef PO_UNP
#undef PO_COMP
        }
    }
    const bf16_t* Og = (const bf16_t*)(p.ws + WS_O); const float* lse = (const float*)(p.ws + WS_LSE);
    for (int task = bid * 8 + wave; task < M_ * 3; task += G * 8) {
        const int t = task / 3, hg = task % 3, hh = hg * 4 + (lane >> 4), c = hh * 64 + cgp * 4;
        const float l0 = lse[(size_t)t * NHA_ + hh], l1 = lse[(size_t)M_ * NHA_ + (size_t)t * NHA_ + hh], l2 = lse[(size_t)2 * M_ * NHA_ + (size_t)t * NHA_ + hh];
        const float lm = fmaxf(l0, fmaxf(l1, l2)); const float e0 = __expf(l0 - lm), e1 = __expf(l1 - lm), e2 = __expf(l2 - lm); const float inv = 1.0f / (e0 + e1 + e2);
        const u32x2 o0 = *(const u32x2*)(Og + (size_t)t * AD_ + c), o1 = *(const u32x2*)(Og + (size_t)M_ * AD_ + (size_t)t * AD_ + c), o2 = *(const u32x2*)(Og + (size_t)2 * M_ * AD_ + (size_t)t * AD_ + c);
        const f32x4 a0 = {bflo(o0.x), bfhi(o0.x), bflo(o0.y), bfhi(o0.y)}, a1 = {bflo(o1.x), bfhi(o1.x), bflo(o1.y), bfhi(o1.y)}, a2 = {bflo(o2.x), bfhi(o2.x), bflo(o2.y), bfhi(o2.y)};
        const f32x4 o = (a0 * e0 + a1 * e1 + a2 * e2) * inv;
        u32x2 w; w.x = cvt_pk_bf16(o[0], o[1]); w.y = cvt_pk_bf16(o[2], o[3]);
        *(u32x2*)(YY + (size_t)t * LDY_ + RW_ + c) = w;
    }
}

__global__ void __launch_bounds__(512, 2) fwd_kernel(Params p) {
    extern __shared__ __attribute__((aligned(16))) unsigned char lds_raw[];
    cg::grid_group grid = cg::this_grid();
    LAS unsigned char* ldsl = (LAS unsigned char*)lds_raw;
    const int bid = blockIdx.x, G = gridDim.x;
    unsigned char* ws = p.ws;
    const int lo = p.ph_lo, hi = p.ph_hi;
#define IN(k) (lo <= (k) && (k) < hi)
#define GSYNC() do { grid.sync(); } while (0)
#define SEAM(k) do { if (IN(k) && IN((k) + 1)) GSYNC(); } while (0)
    bf16_t* Xb = (bf16_t*)(ws + WS_XB); bf16_t* Hh = (bf16_t*)(ws + WS_H); float* Hf = (float*)(ws + WS_HF);
    bf16_t* Wgu = (bf16_t*)(ws + WS_WGU); bf16_t* Wd = (bf16_t*)(ws + WS_WD);

    if (IN(0)) { phase_convert0(p, lds_raw, bid, G); } SEAM(0);
    if (IN(1)) { pg8::Gemm g{Xb, Wgu, M_, 2 * FF_, D_, D_, D_}; pg8::StaticOrder S; S.init(M_, 2 * FF_, G, bid); EpiSwiGLU E{Hh, FF_}; pg8::gemm_phase(ldsl, g, S, E); } SEAM(1);
    if (IN(2)) { pg8::Gemm g{Hh, Wd, M_, D_, FF_, FF_, FF_}; pg8::StaticOrder S; S.init(M_, D_, G, bid); EpiRes E{p.out, p.in[0], D_, ALPHA_, 0.5f}; pg8::gemm_phase(ldsl, g, S, E); } SEAM(2);
    if (IN(3)) { ln_phase(p.out, p.in[5], p.in[6], Hf, Xb, bid, G); } SEAM(3);
    if (IN(4)) {
        pg8::Gemm g{Xb, (bf16_t*)(ws + WS_WIN), M_, NIN_, D_, D_, D_}; pg8::StaticOrder S; S.init(M_, NIN_, G, bid);
        EpiWin E{ws, (long)((unsigned char*)p.out - ws)};
        pg8::gemm_phase(ldsl, g, S, E);
    } SEAM(4);
    if (IN(5)) { phase_prep(p, lds_raw, bid, G); } SEAM(5);
    if (IN(6)) { lora_phase(p, lds_raw, 0, 2, bid, G); } SEAM(6);
    if (IN(7)) { phase_scan_attn(p, lds_raw, bid, G); } SEAM(7);
    if (IN(8)) { lora_phase(p, lds_raw, 2, 3, bid, G); } SEAM(8);
    if (IN(9)) { phase_post(p, bid, G); } SEAM(9);
    if (IN(10)) { pg8::Gemm g{(bf16_t*)((unsigned char*)p.out + DO_YY), (bf16_t*)(ws + WS_WOUT), M_, D_, D_, LDY_, LDY_}; pg8::StaticOrder S; S.init(M_, D_, G, bid); EpiRes E{(float*)(ws + WS_Z2), Hf, D_, ALPHA_, 1.0f}; pg8::gemm_phase(ldsl, g, S, E); } SEAM(10);
    if (IN(11)) { ln_phase((const float*)(ws + WS_Z2), p.in[25], p.in[26], Hf, Xb, bid, G); convert_ffn_weights(p, 27, 28, 29, (float*)lds_raw, bid, G); } SEAM(11);
    if (IN(12)) { pg8::Gemm g{Xb, Wgu, M_, 2 * FF_, D_, D_, D_}; pg8::StaticOrder S; S.init(M_, 2 * FF_, G, bid); EpiSwiGLU E{Hh, FF_}; pg8::gemm_phase(ldsl, g, S, E); } SEAM(12);
    if (IN(13)) { pg8::Gemm g{Hh, Wd, M_, D_, FF_, FF_, FF_}; pg8::StaticOrder S; S.init(M_, D_, G, bid); EpiRes E{p.out, Hf, D_, ALPHA_, 0.5f}; pg8::gemm_phase(ldsl, g, S, E); } SEAM(13);
    if (IN(14)) { ln_phase(p.out, p.in[30], p.in[31], p.out, nullptr, bid, G); }
#undef IN
#undef SEAM
}

extern "C" void kernel_launch(void* const* d_in, const int* in_sizes, int n_in, void* d_out, int out_size, void* d_ws, size_t ws_size, hipStream_t stream) {
    static int grid_blocks = 0;
    if (grid_blocks == 0) {
        int dev = 0, cus = 0, per_cu = 0;
        hipGetDevice(&dev);
        hipDeviceGetAttribute(&cus, hipDeviceAttributeMultiprocessorCount, dev);
        if (hipFuncSetAttribute((const void*)fwd_kernel, hipFuncAttributeMaxDynamicSharedMemorySize, LDS_BYTES) != hipSuccess) { fprintf(stderr, "hipFuncSetAttribute failed\n"); }
        if (hipOccupancyMaxActiveBlocksPerMultiprocessor(&per_cu, (const void*)fwd_kernel, 512, LDS_BYTES) != hipSuccess || per_cu < 1) { fprintf(stderr, "occupancy query: %d\n", per_cu); per_cu = 1; }
        (void)hipGetLastError();
        grid_blocks = cus * 1;
        if (ws_size < 512 * MiB || n_in != 32) fprintf(stderr, "kernel_launch: unexpected ws_size %zu / n_in %d\n", ws_size, n_in);
    }
    Params p{};
    for (int i = 0; i < 32; ++i) p.in[i] = (const float*)d_in[i];
    p.out = (float*)d_out; p.ws = (unsigned char*)d_ws;
#if N_LAUNCH_MODE == 1
    p.ph_lo = 0; p.ph_hi = NPHASE;
    void* args[] = {&p};
    hipError_t e = hipLaunchCooperativeKernel((const void*)fwd_kernel, dim3(grid_blocks), dim3(512), args, LDS_BYTES, stream);
    if (e != hipSuccess) fprintf(stderr, "cooperative launch failed: %s (grid %d)\n", hipGetErrorString(e), grid_blocks);
#else
    for (int ph = 0; ph < NPHASE; ++ph) {
        p.ph_lo = ph; p.ph_hi = ph + 1;
        void* args[] = {&p};
        hipError_t e = hipLaunchCooperativeKernel((const void*)fwd_kernel, dim3(grid_blocks), dim3(512), args, LDS_BYTES, stream);
        if (e != hipSuccess) { fprintf(stderr, "launch %d failed: %s (grid %d)\n", ph, hipGetErrorString(e), grid_blocks); break; }
    }
#endif
}
```

```cpp
#include <hip/hip_runtime.h>
#include <hip/hip_cooperative_groups.h>
#include <cstdio>
namespace cg = cooperative_groups;

#ifndef N_LAUNCH_MODE
#define N_LAUNCH_MODE 1
#endif

#define LAS __attribute__((address_space(3)))
typedef unsigned short bf16_t;
typedef short bf16x8 __attribute__((ext_vector_type(8)));
typedef float f32x4 __attribute__((ext_vector_type(4)));
typedef float f32x2 __attribute__((ext_vector_type(2)));
typedef unsigned u32x4 __attribute__((ext_vector_type(4)));
typedef unsigned u32x2 __attribute__((ext_vector_type(2)));

constexpr int T_ = 8192, B_ = 2, M_ = B_ * T_, D_ = 2048, FF_ = 5632;
constexpr int RW_ = 1280, NHR_ = 20, NHA_ = 12, AD_ = 768;
constexpr int NIN_ = 6656;
constexpr float ALPHA_ = 1.189207115002721f;
constexpr float LN_EPS_ = 1e-5f, GN_EPS_ = 64e-5f;
constexpr int NPHASE = 15;
constexpr int LDY_ = 2048 + 128;
constexpr int LDS_BYTES = 131072;

constexpr size_t MiB = 1048576ull;
constexpr size_t WS_HF = 0;
constexpr size_t WS_WIN = 128 * MiB;
constexpr size_t WS_WOUT = 154 * MiB;
constexpr size_t WS_WLORA = 290 * MiB + 262144;
constexpr size_t WS_WGU = 164 * MiB;
constexpr size_t WS_WD = 208 * MiB;
constexpr size_t WS_XB = 230 * MiB;
constexpr size_t WS_H = 294 * MiB;
constexpr size_t WS_PRKV = 294 * MiB;
constexpr size_t WS_PLORA = 438 * MiB;
constexpr size_t WS_PV = 470 * MiB;
constexpr size_t WS_XLORA = 414 * MiB;
constexpr size_t WS_LW = 164 * MiB;
constexpr size_t WS_LA = 204 * MiB;
constexpr size_t WS_LG = 164 * MiB;
constexpr size_t WS_Y = 248 * MiB;
constexpr size_t WS_LSE = 288 * MiB;
constexpr size_t WS_O = 438 * MiB;
constexpr size_t WS_Z2 = 294 * MiB;
constexpr size_t DO_PQ = 0, DO_PK = 24 * MiB, DO_VT = 48 * MiB, DO_YY = 0;

struct Params {
    const float* in[32];
    float* out;
    unsigned char* ws;
    int ph_lo, ph_hi;
};

__device__ __forceinline__ bf16_t f2bf(float f) { unsigned u = __float_as_uint(f); u += 0x7FFFu + ((u >> 16) & 1u); return (bf16_t)(u >> 16); }
__device__ __forceinline__ float bf2f(bf16_t b) { return __uint_as_float(((unsigned)b) << 16); }
__device__ __forceinline__ unsigned cvt_pk_bf16(float lo, float hi) { unsigned r; asm("v_cvt_pk_bf16_f32 %0, %1, %2" : "=v"(r) : "v"(lo), "v"(hi)); return r; }
__device__ __forceinline__ float bflo(unsigned w) { return __uint_as_float(w << 16); }
__device__ __forceinline__ float bfhi(unsigned w) { return __uint_as_float(w & 0xffff0000u); }
template <int CTRL> __device__ __forceinline__ float dppf(float x) { return __builtin_bit_cast(float, __builtin_amdgcn_update_dpp(0, __builtin_bit_cast(int, x), CTRL, 0xf, 0xf, false)); }
__device__ __forceinline__ int tidx() { int t = threadIdx.x; asm volatile("" : "+v"(t)); return t; }
__device__ __forceinline__ float red16(float x) {
    x += dppf<0xB1>(x); x += dppf<0x4E>(x); x += dppf<0x141>(x); x += dppf<0x128>(x); return x;
}
__device__ __forceinline__ float wave_sum(float x) {
#pragma unroll
    for (int o = 32; o >= 1; o >>= 1) x += __shfl_xor(x, o);
    return x;
}

namespace pg8 {
constexpr int BM = 256, BK = 64, HALF = 128, HTB = HALF * BK * 2, STAGE_BYTES = 8 * HTB, NXCD = 8, WGM = 8;
__device__ __forceinline__ int lds_byte(int r, int c) { const int st = (r >> 4) * 2 + (c >> 5), rr = r & 15, cc = c & 31, ob = rr * 64 + cc * 2; return st * 1024 + (ob ^ (((ob >> 9) & 1) << 5)); }
__device__ __forceinline__ void stage_rc(int b, int& R, int& C) { const int st = b / 1024, sb = b % 1024, swz = sb ^ (((sb >> 9) & 1) << 5); R = (st >> 1) * 16 + swz / 64; C = (st & 1) * 32 + (swz % 64) / 2; }
__device__ __forceinline__ int perm32(int rho) { const int n = rho >> 4, i = rho & 15; return 8 * (i >> 2) + 4 * n + (i & 3); }
struct Unit { int pm, pn; };
struct Gemm { const bf16_t* A; const bf16_t* Bt; int M, N, K, lda, ldb; };
struct StaticOrder {
    int nM, nN, nwg, G, c;
    __device__ void init(int M, int N, int G_, int c_) { nM = M / BM; nN = N / BM; nwg = nM * nN; G = G_; c = c_; }
    __device__ bool next(int i, Unit& u) const {
        const long L = (long)i * G + c; if (L >= nwg) return false;
        int wgid = (int)L; { const int q = nwg / NXCD, r = nwg % NXCD, xcd = wgid % NXCD, off = wgid / NXCD; wgid = (xcd < r ? xcd * (q + 1) : r * (q + 1) + (xcd - r) * q) + off; }
        const int nig = WGM * nN, gid = wgid / nig, fm = gid * WGM, gsz = (nM - fm) < WGM ? (nM - fm) : WGM;
        u.pm = fm + ((wgid % nig) % gsz); u.pn = (wgid % nig) / gsz; return true;
    }
};

template <class Epi>
__device__ __forceinline__ void gemm_phase(LAS unsigned char* lds, const Gemm g, const StaticOrder& S, const Epi& E) {
    const int tid = tidx(), wid = __builtin_amdgcn_readfirstlane(tid >> 6), lane = tid & 63, wr = wid >> 2, wc = wid & 3, fr = lane & 15, fq = lane >> 4;
    int K = g.K, lda_ = g.lda, ldb_ = g.ldb; asm volatile("" : "+s"(K), "+s"(lda_), "+s"(ldb_));
    const int nt = K / BK;
    unsigned voffA[2], voffB[2];
#pragma unroll
    for (int i = 0; i < 2; ++i) { int R, C; stage_rc(tid * 16 + i * 8192, R, C); const int Rb = Epi::PERM ? ((R & ~31) + perm32(R & 31)) : R;
        voffA[i] = (unsigned)(R * lda_ + C) * 2u; voffB[i] = (unsigned)(Rb * ldb_ + C) * 2u; }
    const size_t kstep = (size_t)(BK * 2);
    const size_t hstepA = (size_t)HALF * lda_ * 2, hstepB = (size_t)HALF * ldb_ * 2;
    const size_t tstepA = 2 * hstepA, tstepB = 2 * hstepB;
    const unsigned ldsw = (unsigned)wid * 1024u;
    const int aoff = lds_byte(wr * 64 + fr, fq * 8), boff = lds_byte(wc * 32 + fr, fq * 8);
#define PG8_SA(b, h) (((b) * 2 + (h)) * HTB)
#define PG8_SB(b, h) ((4 + (b) * 2 + (h)) * HTB)
#define PG8_STAGE(bufoff, gbase, voff) do { _Pragma("unroll") for (int _i = 0; _i < 2; ++_i) \
        __builtin_amdgcn_global_load_lds((const unsigned*)((const char*)(gbase) + (voff)[_i]), (LAS unsigned*)(lds + (bufoff) + ldsw + _i * 8192), 16, 0, 0); } while (0)
#define PG8_LDA(dst, b, h) do { _Pragma("unroll") for (int m = 0; m < 4; ++m) _Pragma("unroll") for (int k = 0; k < 2; ++k) dst[m][k] = *(const LAS bf16x8*)(lds + PG8_SA(b, h) + aoff + m * 2048 + k * 1024); } while (0)
#define PG8_LDB(dst, b, h) do { _Pragma("unroll") for (int n = 0; n < 2; ++n) _Pragma("unroll") for (int k = 0; k < 2; ++k) dst[n][k] = *(const LAS bf16x8*)(lds + PG8_SB(b, h) + boff + n * 2048 + k * 1024); } while (0)
#define PG8_MMA(ai, bj, At, Bt) do { __builtin_amdgcn_s_setprio(1); _Pragma("unroll") for (int m = 0; m < 4; ++m) _Pragma("unroll") for (int n = 0; n < 2; ++n) _Pragma("unroll") for (int k = 0; k < 2; ++k) \
        acc[ai][bj][m][n] = __builtin_amdgcn_mfma_f32_16x16x32_bf16(Bt[n][k], At[m][k], acc[ai][bj][m][n], 0, 0, 0); __builtin_amdgcn_s_setprio(0); } while (0)
#define PG8_WAIT_V(n) asm volatile("s_waitcnt vmcnt(" #n ")" ::: "memory")
#define PG8_WAIT_L(n) asm volatile("s_waitcnt lgkmcnt(" #n ")" ::: "memory")
#define PG8_BAR __builtin_amdgcn_s_barrier()
#define PG8_SCHED __builtin_amdgcn_sched_barrier(0)
    Unit cur, nxt; int ui = 0;
    if (!S.next(0, cur)) return;
    f32x4 acc[2][2][4][2];
#pragma unroll
    for (int a = 0; a < 2; ++a)
#pragma unroll
        for (int b = 0; b < 2; ++b)
#pragma unroll
            for (int m = 0; m < 4; ++m)
#pragma unroll
                for (int n = 0; n < 2; ++n) acc[a][b][m][n] = (f32x4){0.f, 0.f, 0.f, 0.f};
    bf16x8 At[4][2], B0[2][2], B1[2][2];
    const char* cA = (const char*)g.A + (size_t)cur.pm * tstepA; const char* cB = (const char*)g.Bt + (size_t)cur.pn * tstepB;
    PG8_STAGE(PG8_SB(0, 0), cB, voffB); PG8_STAGE(PG8_SA(0, 0), cA, voffA); PG8_STAGE(PG8_SB(0, 1), cB + hstepB, voffB); PG8_STAGE(PG8_SA(0, 1), cA + hstepA, voffA);
    if (wr == 1) PG8_BAR;
    PG8_WAIT_V(4); PG8_BAR;
    PG8_STAGE(PG8_SB(1, 0), cB + kstep, voffB); PG8_STAGE(PG8_SA(1, 0), cA + kstep, voffA); PG8_STAGE(PG8_SB(1, 1), cB + hstepB + kstep, voffB);
    PG8_WAIT_V(6); PG8_BAR;
    for (;;) {
        const bool has_next = S.next(ui + 1, nxt);
        const char* nA = has_next ? (const char*)g.A + (size_t)nxt.pm * tstepA : cA; const char* nB = has_next ? (const char*)g.Bt + (size_t)nxt.pn * tstepB : cB;
        for (int t = 0; t < nt; t += 2) {
            const bool last = (t == nt - 2);
            const char* a1 = cA + (size_t)(t + 1) * kstep;
            const char* a2 = last ? nA : cA + (size_t)(t + 2) * kstep; const char* b2 = last ? nB : cB + (size_t)(t + 2) * kstep;
            const char* a3 = a2 + kstep; const char* b3 = b2 + kstep;
            PG8_LDB(B0, 0, 0); PG8_SCHED; PG8_LDA(At, 0, 0); PG8_STAGE(PG8_SA(1, 1), a1 + hstepA, voffA);
            PG8_WAIT_L(8); PG8_BAR; PG8_WAIT_L(0); PG8_MMA(0, 0, At, B0); PG8_BAR; PG8_SCHED;
            PG8_LDB(B1, 0, 1); PG8_STAGE(PG8_SB(0, 0), b2, voffB);
            PG8_BAR; PG8_WAIT_L(0); PG8_MMA(0, 1, At, B1); PG8_BAR;
            PG8_LDA(At, 0, 1); PG8_STAGE(PG8_SA(0, 0), a2, voffA);
            PG8_BAR; PG8_WAIT_L(0); PG8_MMA(1, 0, At, B0); PG8_BAR; PG8_SCHED;
            PG8_STAGE(PG8_SB(0, 1), b2 + hstepB, voffB);
            PG8_WAIT_V(6); PG8_BAR; PG8_MMA(1, 1, At, B1); PG8_BAR;
            PG8_LDB(B0, 1, 0); PG8_SCHED; PG8_LDA(At, 1, 0); PG8_STAGE(PG8_SA(0, 1), a2 + hstepA, voffA);
            PG8_WAIT_L(8); PG8_BAR; PG8_WAIT_L(0); PG8_MMA(0, 0, At, B0); PG8_BAR; PG8_SCHED;
            PG8_LDB(B1, 1, 1); PG8_STAGE(PG8_SB(1, 0), b3, voffB);
            PG8_BAR; PG8_WAIT_L(0); PG8_MMA(0, 1, At, B1); PG8_BAR;
            PG8_LDA(At, 1, 1); PG8_STAGE(PG8_SA(1, 0), a3, voffA);
            PG8_BAR; PG8_WAIT_L(0); PG8_MMA(1, 0, At, B0); PG8_BAR; PG8_SCHED;
            PG8_STAGE(PG8_SB(1, 1), b3 + hstepB, voffB);
            PG8_WAIT_V(6); PG8_BAR; PG8_MMA(1, 1, At, B1); PG8_BAR;
        }
        E(acc, cur, wr, wc, fr, fq);
        if (!has_next) break;
#pragma unroll
        for (int a = 0; a < 2; ++a)
#pragma unroll
            for (int b = 0; b < 2; ++b)
#pragma unroll
                for (int m = 0; m < 4; ++m)
#pragma unroll
                    for (int n = 0; n < 2; ++n) acc[a][b][m][n] = (f32x4){0.f, 0.f, 0.f, 0.f};
        cur = nxt; cA = nA; cB = nB; ++ui;
    }
    PG8_WAIT_V(0);
    if (wr == 0) PG8_BAR;
    PG8_BAR;
#undef PG8_SA
#undef PG8_SB
#undef PG8_STAGE
#undef PG8_LDA
#undef PG8_LDB
#undef PG8_MMA
#undef PG8_WAIT_V
#undef PG8_WAIT_L
#undef PG8_BAR
#undef PG8_SCHED
}
}

typedef f32x4 AccT[2][2][4][2];

__device__ __forceinline__ float silu_f(float x) { return x * __builtin_amdgcn_rcpf(1.0f + __expf(-x)); }

struct EpiSwiGLU {
    static constexpr bool PERM = true;
    bf16_t* H; int ldc;
    __device__ __forceinline__ void operator()(const AccT& acc, const pg8::Unit& u, int wr, int wc, int fr, int fq) const {
        asm volatile("" : "+v"(fr), "+v"(fq));
        const int row0 = u.pm * 256 + wr * 64 + fr, col0 = u.pn * 128 + wc * 32 + 8 * fq;
#pragma unroll
        for (int ai = 0; ai < 2; ++ai)
#pragma unroll
            for (int m = 0; m < 4; ++m) {
                bf16_t* rowp = H + (size_t)(row0 + ai * 128 + m * 16) * ldc + col0;
                const f32x4 g0 = acc[ai][0][m][0], g1 = acc[ai][0][m][1], u0 = acc[ai][1][m][0], u1 = acc[ai][1][m][1];
                u32x4 w;
                w.x = cvt_pk_bf16(silu_f(g0[0]) * u0[0], silu_f(g0[1]) * u0[1]); w.y = cvt_pk_bf16(silu_f(g0[2]) * u0[2], silu_f(g0[3]) * u0[3]);
                w.z = cvt_pk_bf16(silu_f(g1[0]) * u1[0], silu_f(g1[1]) * u1[1]); w.w = cvt_pk_bf16(silu_f(g1[2]) * u1[2], silu_f(g1[3]) * u1[3]);
                *(u32x4*)rowp = w;
            }
    }
};
struct EpiRes {
    static constexpr bool PERM = false;
    float* Z; const float* res; int ldc; float alpha, scale;
    __device__ __forceinline__ void operator()(const AccT& acc, const pg8::Unit& u, int wr, int wc, int fr, int fq) const {
        asm volatile("" : "+v"(fr), "+v"(fq));
        const int row0 = u.pm * 256 + wr * 64 + fr, col0 = u.pn * 256 + wc * 32 + 4 * fq;
#pragma unroll
        for (int ai = 0; ai < 2; ++ai)
#pragma unroll
            for (int m = 0; m < 4; ++m) {
                const size_t off = (size_t)(row0 + ai * 128 + m * 16) * ldc + col0;
#pragma unroll
                for (int bj = 0; bj < 2; ++bj)
#pragma unroll
                    for (int n = 0; n < 2; ++n) {
                        const f32x4 r = *(const f32x4*)(res + off + bj * 128 + n * 16);
                        *(f32x4*)(Z + off + bj * 128 + n * 16) = r * alpha + acc[ai][bj][m][n] * scale;
                    }
            }
    }
};
struct EpiWin {
    static constexpr bool PERM = true;
    unsigned char* ws; long delta;
    __device__ __forceinline__ void operator()(const AccT& acc, const pg8::Unit& u, int wr, int wc, int fr, int fq) const {
        asm volatile("" : "+v"(fr), "+v"(fq));
        const int row0 = u.pm * 256 + wr * 64 + fr, cl = wc * 32 + 8 * fq;
        if (u.pn == 15 || u.pn == 16) {
            const int colt = (u.pn - 15) * 256 + cl;
            float* Plora = (float*)(ws + WS_PLORA);
#pragma unroll
            for (int ai = 0; ai < 2; ++ai)
#pragma unroll
                for (int m = 0; m < 4; ++m) {
                    float* rowp = Plora + (size_t)(row0 + ai * 128 + m * 16) * 512 + colt;
#pragma unroll
                    for (int bj = 0; bj < 2; ++bj)
#pragma unroll
                        for (int n = 0; n < 2; ++n) *(f32x4*)(rowp + bj * 128 + n * 4) = acc[ai][bj][m][n];
                }
        } else {
            size_t boff; int ldc, colt; bool inws = true;
            if (u.pn < 15) { boff = WS_PRKV; ldc = 3840; colt = u.pn * 256; }
            else { const int t = (u.pn - 17) / 3; inws = (t == 2); boff = (t == 0) ? DO_PQ : (t == 1 ? DO_PK : WS_PV); ldc = 768; colt = ((u.pn - 17) % 3) * 256; }
            bf16_t* base = (bf16_t*)(ws + (long)boff + (inws ? 0l : delta));
#pragma unroll
            for (int ai = 0; ai < 2; ++ai)
#pragma unroll
                for (int m = 0; m < 4; ++m) {
                    bf16_t* rowp = base + (size_t)(row0 + ai * 128 + m * 16) * ldc + colt + cl;
#pragma unroll
                    for (int bj = 0; bj < 2; ++bj) {
                        const f32x4 v0 = acc[ai][bj][m][0], v1 = acc[ai][bj][m][1];
                        u32x4 w; w.x = cvt_pk_bf16(v0[0], v0[1]); w.y = cvt_pk_bf16(v0[2], v0[3]); w.z = cvt_pk_bf16(v1[0], v1[1]); w.w = cvt_pk_bf16(v1[2], v1[3]);
                        *(u32x4*)(rowp + bj * 128) = w;
                    }
                }
        }
    }
};
__device__ __forceinline__ int map_row(int n, int mode) {
    if (mode == 1) return (n >> 7) * 256 + (n & 127);
    if (mode == 2) return (n >> 7) * 256 + 128 + (n & 127);
    if (mode == 3) return n < 4288 ? n : n + 64;
    return n;
}
__device__ void convert_weight(const float* __restrict__ W, int K, int N, bf16_t* __restrict__ Wt, int ldk, int mode, float* tile, int bid, int G) {
    const int tid = tidx(), kr = tid >> 4, nc = (tid & 15) * 4, kp = tid & 31, nr = tid >> 5;
    const int tn_n = N / 64, tn_k = K / 64, ntile = tn_n * tn_k;
    int t = bid; if (t >= ntile) return;
    f32x4 v0, v1;
    { const int tk = t / tn_n, tn = t % tn_n; const float* src = W + (size_t)(tk * 64 + kr) * N + tn * 64 + nc; v0 = *(const f32x4*)src; v1 = *(const f32x4*)(src + (size_t)32 * N); }
    while (t < ntile) {
        const int tk = t / tn_n, tn = t % tn_n, tnext = t + G;
        const f32x4 c0 = v0, c1 = v1;
        if (tnext < ntile) { const int tk2 = tnext / tn_n, tn2 = tnext % tn_n; const float* src = W + (size_t)(tk2 * 64 + kr) * N + tn2 * 64 + nc; v0 = *(const f32x4*)src; v1 = *(const f32x4*)(src + (size_t)32 * N); }
#pragma unroll
        for (int j = 0; j < 4; ++j) { tile[kr * 65 + nc + j] = c0[j]; tile[(32 + kr) * 65 + nc + j] = c1[j]; }
        __syncthreads();
        const int drow0 = map_row(tn * 64, mode);
#pragma unroll
        for (int i = 0; i < 4; ++i) { const int n = nr + 16 * i; const float a = tile[(2 * kp) * 65 + n], bq = tile[(2 * kp + 1) * 65 + n];
            *(unsigned*)(Wt + (size_t)(drow0 + n) * ldk + tk * 64 + 2 * kp) = cvt_pk_bf16(a, bq); }
        __syncthreads();
        t = tnext;
    }
}
__device__ void convert_ffn_weights(const Params& p, int ig, int iu, int idn, float* tile, int bid, int G) {
    bf16_t* Wgu = (bf16_t*)(p.ws + WS_WGU); bf16_t* Wd = (bf16_t*)(p.ws + WS_WD);
    convert_weight(p.in[ig], D_, FF_, Wgu, D_, 1, tile, bid, G);
    convert_weight(p.in[iu], D_, FF_, Wgu, D_, 2, tile, (bid + 85) % G, G);
    convert_weight(p.in[idn], FF_, D_, Wd, FF_, 0, tile, (bid + 170) % G, G);
}

__device__ void ln_phase(const float* __restrict__ Z, const float* __restrict__ gam, const float* __restrict__ bet, float* outf, bf16_t* outb, int bid, int G) {
    const int tid = tidx(), wave = tid >> 6, lane = tid & 63;
    f32x4 gv[8], bv[8];
#pragma unroll
    for (int i = 0; i < 8; ++i) { gv[i] = *(const f32x4*)(gam + i * 256 + lane * 4); bv[i] = *(const f32x4*)(bet + i * 256 + lane * 4); }
    for (int row = bid * 8 + wave; row < M_; row += G * 8) {
        const float* zr = Z + (size_t)row * D_;
        f32x4 x[8]; float s = 0.f;
#pragma unroll
        for (int i = 0; i < 8; ++i) { x[i] = *(const f32x4*)(zr + i * 256 + lane * 4); s += (x[i][0] + x[i][1]) + (x[i][2] + x[i][3]); }
        s = wave_sum(s); const float mean = s * (1.0f / D_);
        float q = 0.f;
#pragma unroll
        for (int i = 0; i < 8; ++i) { x[i] = x[i] - mean; q += (x[i][0] * x[i][0] + x[i][1] * x[i][1]) + (x[i][2] * x[i][2] + x[i][3] * x[i][3]); }
        q = wave_sum(q); const float rstd = 1.0f / sqrtf(q * (1.0f / D_) + LN_EPS_);
#pragma unroll
        for (int i = 0; i < 8; ++i) {
            const f32x4 o = x[i] * rstd * gv[i] + bv[i];
            if (outf) *(f32x4*)(outf + (size_t)row * D_ + i * 256 + lane * 4) = o;
            if (outb) { u32x2 w; w.x = cvt_pk_bf16(o[0], o[1]); w.y = cvt_pk_bf16(o[2], o[3]); *(u32x2*)(outb + (size_t)row * D_ + i * 256 + lane * 4) = w; }
        }
    }
}

__device__ void phase_convert0(const Params& p, unsigned char* lds, int bid, int G) {
    float* tile = (float*)lds;
    const int tid = tidx();
    convert_ffn_weights(p, 2, 3, 4, tile, bid, G);
    convert_weight(p.in[7], D_, 6592, (bf16_t*)(p.ws + WS_WIN), D_, 3, tile, bid, G);
    convert_weight(p.in[24], D_, D_, (bf16_t*)(p.ws + WS_WOUT), LDY_, 0, tile, (bid + 128) % G, G);
    { unsigned* z = (unsigned*)((bf16_t*)(p.ws + WS_WIN) + (size_t)4288 * D_); for (int i = bid * 512 + tid; i < 64 * D_ / 2; i += G * 512) z[i] = 0u; }
    { const f32x4* x4 = (const f32x4*)p.in[0]; u32x2* o = (u32x2*)(p.ws + WS_XB);
      for (int i = bid * 512 + tid; i < M_ * D_ / 4; i += G * 512) { const f32x4 v = x4[i]; u32x2 w; w.x = cvt_pk_bf16(v[0], v[1]); w.y = cvt_pk_bf16(v[2], v[3]); o[i] = w; } }
}

__device__ void phase_prep(const Params& p, unsigned char* lds, int bid, int G) {
    const int tid = tidx();
    {
        bf16_t* WL = (bf16_t*)(p.ws + WS_WLORA);
        const float* s0 = p.in[15]; const float* s1 = p.in[17]; const float* s2 = p.in[18];
        for (int i = bid * 512 + tid; i < 1280 * 256; i += G * 512) {
            const int n = i >> 8, k = i & 255;
            WL[i] = (k < 96) ? f2bf(s0[(size_t)k * 1280 + n]) : (bf16_t)0;
            WL[1280 * 256 + i] = (k < 96) ? f2bf(s1[(size_t)k * 1280 + n]) : (bf16_t)0;
            WL[2 * 1280 * 256 + i] = f2bf(s2[(size_t)k * 1280 + n]);
        }
    }
    {
        const float* PL = (const float*)(p.ws + WS_PLORA); bf16_t* XL = (bf16_t*)(p.ws + WS_XLORA);
        const float* mu_w = p.in[11]; const float* mu_a = p.in[12]; const float* mu_g = p.in[13];
        for (int i = bid * 512 + tid; i < M_ * 768; i += G * 512) {
            const int t = i / 768, c = i % 768; float o = 0.f;
            int src = -1; float mu = 0.f; int kind = 0;
            if (c < 96) { src = c; mu = mu_w[c]; kind = 0; }
            else if (c >= 256 && c < 352) { src = 96 + (c - 256); mu = mu_a[c - 256]; kind = 1; }
            else if (c >= 512) { src = 192 + (c - 512); mu = mu_g[c - 512]; kind = 2; }
            if (src >= 0) {
                const float z = PL[(size_t)t * 512 + src]; const float zp = (t % T_) ? PL[(size_t)(t - 1) * 512 + src] : 0.f;
                const float s = z + (zp - z) * mu;
                o = (kind == 0) ? tanhf(s) : (kind == 1 ? s : 1.0f / (1.0f + expf(-s)));
            }
            XL[i] = f2bf(o);
        }
    }
    {
        bf16_t* Pq = (bf16_t*)((unsigned char*)p.out + DO_PQ); bf16_t* Pk = (bf16_t*)((unsigned char*)p.out + DO_PK);
        const int* pos = (const int*)p.in[1];
        for (int i = bid * 512 + tid; i < M_ * 2 * NHA_ * 8; i += G * 512) {
            const int j = i & 7, hh = (i >> 3) % NHA_, qk = (i / (8 * NHA_)) & 1, t = i / (16 * NHA_);
            bf16_t* P = (qk ? Pk : Pq) + (size_t)t * AD_ + hh * 64;
            const float invf = exp2f(-(float)j * 2.3664460711655217f);
            const float ang = (float)pos[t] * invf; const double rv = (double)ang * 0.15915494309189535; const float rev = (float)(rv - rint(rv));
            const float sn = __builtin_amdgcn_sinf(rev), cs = __builtin_amdgcn_cosf(rev);
            const float x1 = bf2f(P[j]), x2 = bf2f(P[8 + j]);
            P[j] = f2bf(x1 * cs - x2 * sn); P[8 + j] = f2bf(x2 * cs + x1 * sn);
        }
    }
    {
        const bf16_t* Pv = (const bf16_t*)(p.ws + WS_PV); bf16_t* VT = (bf16_t*)((unsigned char*)p.out + DO_VT);
        bf16_t* tl = (bf16_t*)lds;
        for (int job = bid; job < (M_ / 256) * NHA_; job += G) {
            const int hh = job % NHA_, tb = job / NHA_, tok0 = tb * 256, b = tok0 / T_, t0 = tok0 % T_;
            __syncthreads();
            for (int i = tid; i < 256 * 32; i += 512) { const int tr = i >> 5, cp = i & 31; *(unsigned*)(tl + tr * 66 + cp * 2) = *(const unsigned*)(Pv + (size_t)(tok0 + tr) * AD_ + hh * 64 + cp * 2); }
            __syncthreads();
#pragma unroll
            for (int g = 0; g < 3; ++g) {
                const int sh = 2 * g, d = 1 << sh, per = 256 >> sh;
                bf16_t* dst = VT + (size_t)g * M_ * AD_ + ((size_t)(b * NHA_ + hh) * 64) * T_;
                for (int o = tid; o < 64 * 256; o += 512) {
                    const int e = o >> 8, j = o & 255, r = j / per, q = j % per, tloc = q * d + r;
                    dst[(size_t)e * T_ + r * (T_ >> sh) + (t0 >> sh) + q] = tl[tloc * 66 + e];
                }
            }
        }
        __syncthreads();
    }
}

__device__ __forceinline__ float lora_act(int which, float x, float c) {
    if (which == 0) { const float z = -(c + x); const float sp = fmaxf(z, 0.f) + __logf(1.0f + __expf(-fabsf(z))); return __expf(-sp - 0.5f); }
    if (which == 1) return __builtin_amdgcn_rcpf(1.0f + __expf(-(c + x)));
    return x;
}
__device__ void lora_phase(const Params& p, unsigned char* lds, int wlo, int whi, int bid, int G) {
    const int tid = tidx(), wave = tid >> 6, lane = tid & 63, rl = lane & 15, gq = lane >> 4;
    const bf16_t* XL = (const bf16_t*)(p.ws + WS_XLORA); const bf16_t* WL = (const bf16_t*)(p.ws + WS_WLORA);
    unsigned char* Ash = lds;
    unsigned char* Bsh = lds + 128 * 528;
    asm volatile("" : "+s"(wlo), "+s"(whi));
    const int nw = whi - wlo, nitem = 128 * nw * 2;
    for (int item = bid; item < nitem; item += G) {
        const int half = item & 1, which = wlo + (item >> 1) % nw, rb = (item >> 1) / nw;
        const int K = (which == 2) ? 256 : 128, koff = which * 256, cpr = K / 8;
        bf16_t* Ob = (bf16_t*)(p.ws + (which == 0 ? WS_LW : (which == 1 ? WS_LA : WS_LG)));
        const float* cvec = (which == 0) ? p.in[14] : p.in[16];
        __syncthreads();
        for (int c = tid; c < 128 * cpr; c += 512) { const int r = c / cpr, ck = c % cpr; *(u32x4*)(Ash + r * 528 + ck * 16) = *(const u32x4*)(XL + (size_t)(rb * 128 + r) * 768 + koff + ck * 8); }
        const int nbc = (64 * cpr) / 512;
        u32x4 breg[4];
#pragma unroll
        for (int j = 0; j < 4; ++j) if (j < nbc) { const int c = tid + 512 * j, r = c / cpr, ck = c % cpr; breg[j] = *(const u32x4*)(WL + (size_t)which * 1280 * 256 + (size_t)(half * 640 + r) * 256 + ck * 8); }
        for (int cb = 0; cb < 10; ++cb) {
            const int col0 = (half * 10 + cb) * 64;
            __syncthreads();
#pragma unroll
            for (int j = 0; j < 4; ++j) if (j < nbc) { const int c = tid + 512 * j, r = c / cpr, ck = c % cpr; *(u32x4*)(Bsh + r * 528 + ck * 16) = breg[j]; }
            __syncthreads();
            if (cb + 1 < 10) {
#pragma unroll
                for (int j = 0; j < 4; ++j) if (j < nbc) { const int c = tid + 512 * j, r = c / cpr, ck = c % cpr; breg[j] = *(const u32x4*)(WL + (size_t)which * 1280 * 256 + (size_t)(col0 + 64 + r) * 256 + ck * 8); }
            }
            f32x4 acc[4];
#pragma unroll
            for (int nt = 0; nt < 4; ++nt) acc[nt] = (f32x4){0.f, 0.f, 0.f, 0.f};
            for (int ks = 0; ks < K / 32; ++ks) {
                const bf16x8 Af = *(const bf16x8*)(Ash + (16 * wave + rl) * 528 + ks * 64 + gq * 16);
#pragma unroll
                for (int nt = 0; nt < 4; ++nt) { const bf16x8 Bf = *(const bf16x8*)(Bsh + (16 * nt + rl) * 528 + ks * 64 + gq * 16); acc[nt] = __builtin_amdgcn_mfma_f32_16x16x32_bf16(Bf, Af, acc[nt], 0, 0, 0); }
            }
            const size_t row = (size_t)rb * 128 + 16 * wave + rl;
#pragma unroll
            for (int nt = 0; nt < 4; ++nt) {
                const int col = col0 + 16 * nt + 4 * gq; f32x4 cv = {0.f, 0.f, 0.f, 0.f};
                if (which != 2) cv = *(const f32x4*)(cvec + col);
                u32x2 w; w.x = cvt_pk_bf16(lora_act(which, acc[nt][0], cv[0]), lora_act(which, acc[nt][1], cv[1])); w.y = cvt_pk_bf16(lora_act(which, acc[nt][2], cv[2]), lora_act(which, acc[nt][3], cv[3]));
                *(u32x2*)(Ob + row * RW_ + col) = w;
            }
        }
    }
    __syncthreads();
}

__device__ void scan_unit(const Params& p, unsigned char* lds, int bh, int qd) {
    const int tid = tidx(), wave = tid >> 6, lane = tid & 63;
    const int b = bh / NHR_, h = bh % NHR_;
    float* bufX = (float*)lds;
    float* bufV = (float*)(lds + 81920);
    float* bufY = (float*)(lds + 81920 + 4096);
    const bf16_t* Prkv = (const bf16_t*)(p.ws + WS_PRKV); const bf16_t* Lw = (const bf16_t*)(p.ws + WS_LW); const bf16_t* La = (const bf16_t*)(p.ws + WS_LA);
    bf16_t* Y = (bf16_t*)(p.ws + WS_Y);
    const bool loader = wave >= 4;
    const int ts = lane >> 4, cg = lane & 15, ch = h * 64 + cg * 4;
    f32x4 mu_r = {0, 0, 0, 0}, mu_k = mu_r, mu_v = mu_r, k_k = mu_r, k_a = mu_r;
    if (loader) { mu_r = *(const f32x4*)(p.in[8] + ch); mu_k = *(const f32x4*)(p.in[9] + ch); mu_v = *(const f32x4*)(p.in[10] + ch); k_k = *(const f32x4*)(p.in[19] + ch); k_a = *(const f32x4*)(p.in[20] + ch); }
    const int lw = wave - 4;
    f32x4 S = {0.f, 0.f, 0.f, 0.f};
    const int rowl = 4 * (wave & 3) + (lane >> 4);

    struct LReg { u32x2 rr, kr, vr, rp, kp, vp, ew, av; };
#define SC_ISSUE(cc, R, gi) { const int tl_ = 4 * (lw + 4 * (gi)) + ts, tseq_ = (cc) * 32 + tl_; const size_t tok_ = (size_t)b * T_ + tseq_; const bf16_t* pr_ = Prkv + tok_ * 3840 + ch; \
        R.rr = *(const u32x2*)pr_; R.kr = *(const u32x2*)(pr_ + 1280); R.vr = *(const u32x2*)(pr_ + 2560); \
        R.rp = (u32x2){0u, 0u}; R.kp = R.rp; R.vp = R.rp; \
        if (tseq_ > 0) { R.rp = *(const u32x2*)(pr_ - 3840); R.kp = *(const u32x2*)(pr_ - 3840 + 1280); R.vp = *(const u32x2*)(pr_ - 3840 + 2560); } \
        R.ew = *(const u32x2*)(Lw + tok_ * 1280 + ch); R.av = *(const u32x2*)(La + tok_ * 1280 + ch); }
#define SC_PROC(buf_, R, gi) { const int tl_ = 4 * (lw + 4 * (gi)) + ts; \
        const f32x4 r0 = {bflo(R.rr.x), bfhi(R.rr.x), bflo(R.rr.y), bfhi(R.rr.y)}, r1 = {bflo(R.rp.x), bfhi(R.rp.x), bflo(R.rp.y), bfhi(R.rp.y)}; \
        const f32x4 k0 = {bflo(R.kr.x), bfhi(R.kr.x), bflo(R.kr.y), bfhi(R.kr.y)}, k1 = {bflo(R.kp.x), bfhi(R.kp.x), bflo(R.kp.y), bfhi(R.kp.y)}; \
        const f32x4 v0 = {bflo(R.vr.x), bfhi(R.vr.x), bflo(R.vr.y), bfhi(R.vr.y)}, v1 = {bflo(R.vp.x), bfhi(R.vp.x), bflo(R.vp.y), bfhi(R.vp.y)}; \
        const f32x4 ew = {bflo(R.ew.x), bfhi(R.ew.x), bflo(R.ew.y), bfhi(R.ew.y)}, av = {bflo(R.av.x), bfhi(R.av.x), bflo(R.av.y), bfhi(R.av.y)}; \
        const f32x4 r = r0 + (r1 - r0) * mu_r, k = k0 + (k1 - k0) * mu_k, v = v0 + (v1 - v0) * mu_v; \
        f32x4 dec; dec[0] = __builtin_amdgcn_exp2f(ew[0] * -1.4426950408889634f); dec[1] = __builtin_amdgcn_exp2f(ew[1] * -1.4426950408889634f); dec[2] = __builtin_amdgcn_exp2f(ew[2] * -1.4426950408889634f); dec[3] = __builtin_amdgcn_exp2f(ew[3] * -1.4426950408889634f); \
        const f32x4 kku = k * k_k; float s1 = (kku[0] * kku[0] + kku[1] * kku[1]) + (kku[2] * kku[2] + kku[3] * kku[3]); s1 = red16(s1); \
        const float rn = 1.0f / fmaxf(sqrtf(s1), 1e-12f); const f32x4 kk = kku * rn; const f32x4 k2 = k * (1.0f + (av - 1.0f) * k_a); \
        float* X = bufX + ((size_t)((buf_) * 32 + tl_)) * 320 + cg * 4; \
        *(f32x4*)(X) = dec; *(f32x4*)(X + 64) = -kk; *(f32x4*)(X + 128) = kk * av; *(f32x4*)(X + 192) = k2; *(f32x4*)(X + 256) = r; \
        if ((cg >> 2) == qd) *(f32x4*)(bufV + ((buf_) * 32 + tl_) * 16 + (cg & 3) * 4) = v; }
    LReg A0, A1, B0, B1;
    auto store_y = [&](int c, int buf) {
        const int lt = tid - 256, tl = lt >> 3, pr = lt & 7;
        const float y0 = bufY[(buf * 32 + tl) * 16 + 2 * pr], y1 = bufY[(buf * 32 + tl) * 16 + 2 * pr + 1];
        *(unsigned*)(Y + ((size_t)b * T_ + c * 32 + tl) * 1280 + h * 64 + 16 * qd + 2 * pr) = cvt_pk_bf16(y0, y1);
    };

    __syncthreads();
    if (loader) { SC_ISSUE(0, A0, 0); SC_ISSUE(0, A1, 1); SC_PROC(0, A0, 0); SC_PROC(0, A1, 1); SC_ISSUE(1, A0, 0); SC_ISSUE(1, A1, 1); }
    __syncthreads();
    for (int c = 0; c < T_ / 32; ++c) {
        const int buf = c & 1;
        if (!loader) {
            const float* Xc = bufX + (size_t)(buf * 32) * 320 + cg * 4;
            const float* Vc = bufV + (buf * 32) * 16 + rowl;
#define SC_LD(i, W, A, B, K, R, V) { const float* X_ = Xc + (i) * 320; W = *(const f32x4*)X_; A = *(const f32x4*)(X_ + 64); B = *(const f32x4*)(X_ + 128); K = *(const f32x4*)(X_ + 192); R = *(const f32x4*)(X_ + 256); V = Vc[(i) * 16]; }
#define SC_STEP(tt, W, A, B, K, R, V) { \
                f32x2 pa_ = (f32x2){S[0], S[1]} * (f32x2){A[0], A[1]}; pa_ = __builtin_elementwise_fma((f32x2){S[2], S[3]}, (f32x2){A[2], A[3]}, pa_); float sa = pa_.x + pa_.y; sa = red16(sa); \
                S = S * W + B * sa + K * V; \
                f32x2 py_ = (f32x2){S[0], S[1]} * (f32x2){R[0], R[1]}; py_ = __builtin_elementwise_fma((f32x2){S[2], S[3]}, (f32x2){R[2], R[3]}, py_); float y = py_.x + py_.y; y = red16(y); \
                ykeep = (cg == ((tt) & 15)) ? y : ykeep; \
                if (((tt) & 15) == 15) bufY[(buf * 32 + ((tt) - 15) + cg) * 16 + rowl] = ykeep; }
            f32x4 w0, a0, b0, k0, r0, w1, a1, b1, k1, r1, w2, a2, b2, k2, r2, w3, a3, b3, k3, r3; float v0, v1, v2, v3; float ykeep = 0.f;
            SC_LD(0, w0, a0, b0, k0, r0, v0); SC_LD(1, w1, a1, b1, k1, r1, v1);
#pragma unroll
            for (int t = 0; t < 32; t += 2) {
                SC_LD((t + 2 < 32 ? t + 2 : 31), w2, a2, b2, k2, r2, v2);
                SC_STEP(t, w0, a0, b0, k0, r0, v0);
                SC_LD((t + 3 < 32 ? t + 3 : 31), w3, a3, b3, k3, r3, v3);
                SC_STEP(t + 1, w1, a1, b1, k1, r1, v1);
                w0 = w2; a0 = a2; b0 = b2; k0 = k2; r0 = r2; v0 = v2; w1 = w3; a1 = a3; b1 = b3; k1 = k3; r1 = r3; v1 = v3;
            }
#undef SC_LD
#undef SC_STEP
        } else {
            { const int c2 = (c + 2 < T_ / 32) ? c + 2 : T_ / 32 - 1; SC_ISSUE(c2, B0, 0); SC_ISSUE(c2, B1, 1); }
            if (c + 1 < T_ / 32) { SC_PROC(buf ^ 1, A0, 0); SC_PROC(buf ^ 1, A1, 1); }
            if (c > 0) store_y(c - 1, buf ^ 1);
            A0 = B0; A1 = B1;
        }
        __syncthreads();
    }
    if (loader) store_y(T_ / 32 - 1, 1);
    __syncthreads();
}

__device__ void attn_item(const Params& p, unsigned char* lds, int item) {
    const int tid = tidx(), wave = tid >> 6, lane = tid & 63, qn = lane & 15, gq = lane >> 4;
    const int g = item / 1536, rem = item % 1536, b = rem / 768, hh = (rem >> 6) % NHA_, rn = rem & 63;
    const int sh = 2 * g, d = 1 << sh, L = T_ >> sh, nb = 64 >> sh, r = rn / nb, n = rn % nb;
    const bf16_t* Pq = (const bf16_t*)((unsigned char*)p.out + DO_PQ); const bf16_t* Pk = (const bf16_t*)((unsigned char*)p.out + DO_PK);
    const bf16_t* VT = (const bf16_t*)((unsigned char*)p.out + DO_VT) + (size_t)g * M_ * AD_ + ((size_t)(b * NHA_ + hh) * 64) * T_;
    bf16_t* Og = (bf16_t*)(p.ws + WS_O) + (size_t)g * M_ * AD_; float* lse = (float*)(p.ws + WS_LSE) + (size_t)g * M_ * NHA_;
    unsigned char* Ksh = lds;
    unsigned char* Vsh = lds + 256 * 144;
    __syncthreads();
#pragma unroll
    for (int i = 0; i < 4; ++i) {
        const int chunk = tid + 512 * i, kap = chunk >> 3, part = chunk & 7;
        const int lp = 128 * (n - 1) + kap; u32x4 val = {0u, 0u, 0u, 0u};
        if (lp >= 0) val = *(const u32x4*)(Pk + ((size_t)b * T_ + (size_t)lp * d + r) * AD_ + hh * 64 + part * 8);
        const int row = (kap & 0xE0) | (((kap >> 2) & 1) << 4) | (((kap >> 3) & 3) << 2) | (kap & 3);
        *(u32x4*)(Ksh + row * 144 + part * 16) = val;
    }
#pragma unroll
    for (int i = 0; i < 4; ++i) {
        const int chunk = tid + 512 * i, e = chunk >> 5, part = chunk & 31, k0 = part * 8;
        u32x4 val = {0u, 0u, 0u, 0u};
        if (n > 0 || k0 >= 128) val = *(const u32x4*)(VT + (size_t)e * T_ + r * L + 128 * (n - 1) + k0);
        *(u32x4*)(Vsh + e * 528 + part * 16) = val;
    }
    const int q = 16 * wave + qn; const size_t qtok = (size_t)b * T_ + (size_t)(128 * n + q) * d + r;
    const bf16x8 Q0 = *(const bf16x8*)(Pq + qtok * AD_ + hh * 64 + gq * 8), Q1 = *(const bf16x8*)(Pq + qtok * AD_ + hh * 64 + 32 + gq * 8);
    __syncthreads();
    const int s0 = wave >> 1;
    f32x4 sacc[5][2];
#pragma unroll
    for (int st = 0; st < 5; ++st)
#pragma unroll
        for (int bb = 0; bb < 2; ++bb) {
            const int row = (s0 + st) * 32 + bb * 16 + qn;
            const bf16x8 K0 = *(const bf16x8*)(Ksh + row * 144 + gq * 16), K1 = *(const bf16x8*)(Ksh + row * 144 + 64 + gq * 16);
            f32x4 a = {0.f, 0.f, 0.f, 0.f};
            a = __builtin_amdgcn_mfma_f32_16x16x32_bf16(K0, Q0, a, 0, 0, 0);
            a = __builtin_amdgcn_mfma_f32_16x16x32_bf16(K1, Q1, a, 0, 0, 0);
            sacc[st][bb] = a;
        }
    const float SC = 0.125f * 1.4426950408889634f;
    float mx = -INFINITY;
#pragma unroll
    for (int st = 0; st < 5; ++st)
#pragma unroll
        for (int bb = 0; bb < 2; ++bb)
#pragma unroll
            for (int i = 0; i < 4; ++i) {
                const int kap = 32 * (s0 + st) + 8 * gq + 4 * bb + i, rel = q + 128 - kap;
                const bool valid = (rel >= 0) && (rel <= 128) && (n > 0 || kap >= 128);
                const float sv = valid ? sacc[st][bb][i] * SC : -INFINITY;
                sacc[st][bb][i] = sv; mx = fmaxf(mx, sv);
            }
    mx = fmaxf(mx, __shfl_xor(mx, 16)); mx = fmaxf(mx, __shfl_xor(mx, 32));
    float den = 0.f; bf16x8 Pf[5];
#pragma unroll
    for (int st = 0; st < 5; ++st) {
        float pv[8];
#pragma unroll
        for (int bb = 0; bb < 2; ++bb)
#pragma unroll
            for (int i = 0; i < 4; ++i) { const float pe = __builtin_amdgcn_exp2f(sacc[st][bb][i] - mx); pv[bb * 4 + i] = pe; den += pe; }
        u32x4 w; w.x = cvt_pk_bf16(pv[0], pv[1]); w.y = cvt_pk_bf16(pv[2], pv[3]); w.z = cvt_pk_bf16(pv[4], pv[5]); w.w = cvt_pk_bf16(pv[6], pv[7]);
        Pf[st] = __builtin_bit_cast(bf16x8, w);
    }
    den += __shfl_xor(den, 16); den += __shfl_xor(den, 32);
    f32x4 oacc[4];
#pragma unroll
    for (int et = 0; et < 4; ++et) oacc[et] = (f32x4){0.f, 0.f, 0.f, 0.f};
#pragma unroll
    for (int st = 0; st < 5; ++st)
#pragma unroll
        for (int et = 0; et < 4; ++et) {
            const bf16x8 Vf = *(const bf16x8*)(Vsh + (16 * et + qn) * 528 + ((s0 + st) * 32 + 8 * gq) * 2);
            oacc[et] = __builtin_amdgcn_mfma_f32_16x16x32_bf16(Vf, Pf[st], oacc[et], 0, 0, 0);
        }
    const float inv = 1.0f / den;
#pragma unroll
    for (int et = 0; et < 4; ++et) {
        u32x2 w; w.x = cvt_pk_bf16(oacc[et][0] * inv, oacc[et][1] * inv); w.y = cvt_pk_bf16(oacc[et][2] * inv, oacc[et][3] * inv);
        *(u32x2*)(Og + qtok * AD_ + hh * 64 + 16 * et + 4 * gq) = w;
    }
    if (gq == 0) lse[qtok * NHA_ + hh] = mx * 0.6931471805599453f + logf(den);
}

__device__ void phase_scan_attn(const Params& p, unsigned char* lds, int bid, int G) {
    constexpr int NSCAN = 160, NITEM = 3 * 1536;
    if (G > NSCAN) {
        if (bid < NSCAN) { const int xcd = bid & 7, slot = bid >> 3; scan_unit(p, lds, xcd * 5 + (slot >> 2), slot & 3); }
        else { for (int it = bid - NSCAN; it < NITEM; it += G - NSCAN) attn_item(p, lds, it); }
    } else {
        for (int u = bid; u < NSCAN; u += G) scan_unit(p, lds, u >> 2, u & 3);
        for (int it = bid; it < NITEM; it += G) attn_item(p, lds, it);
    }
    __syncthreads();
}

__device__ void phase_post(const Params& p, int bid, int G) {
    const int tid = tidx(), wave = tid >> 6, lane = tid & 63, cgp = lane & 15;
    const bf16_t* Prkv = (const bf16_t*)(p.ws + WS_PRKV); const bf16_t* La = (const bf16_t*)(p.ws + WS_LA); const bf16_t* Lg = (const bf16_t*)(p.ws + WS_LG);
    const bf16_t* Ys = (const bf16_t*)(p.ws + WS_Y); bf16_t* YY = (bf16_t*)((unsigned char*)p.out + DO_YY);
    {
        const int gw = bid * 8 + wave, nslot = (G * 8) / 5;
        if (gw < nslot * 5) {
            const int hg = gw % 5, ch = hg * 256 + lane * 4;
            const f32x4 mu_r = *(const f32x4*)(p.in[8] + ch), mu_k = *(const f32x4*)(p.in[9] + ch), mu_v = *(const f32x4*)(p.in[10] + ch);
            const f32x4 k_a = *(const f32x4*)(p.in[20] + ch), r_k = *(const f32x4*)(p.in[21] + ch), gng = *(const f32x4*)(p.in[22] + ch), gnb = *(const f32x4*)(p.in[23] + ch);
#define PO_LOAD(t, S) u32x2 S##rr, S##kr, S##vr, S##rp = {0u, 0u}, S##kp = {0u, 0u}, S##vp = {0u, 0u}, S##a2, S##g2, S##y2; { const bf16_t* pr = Prkv + (size_t)(t) * 3840 + ch; \
                S##rr = *(const u32x2*)pr; S##kr = *(const u32x2*)(pr + 1280); S##vr = *(const u32x2*)(pr + 2560); \
                if (((t) % T_) > 0) { S##rp = *(const u32x2*)(pr - 3840); S##kp = *(const u32x2*)(pr - 3840 + 1280); S##vp = *(const u32x2*)(pr - 3840 + 2560); } \
                S##a2 = *(const u32x2*)(La + (size_t)(t) * 1280 + ch); S##g2 = *(const u32x2*)(Lg + (size_t)(t) * 1280 + ch); S##y2 = *(const u32x2*)(Ys + (size_t)(t) * 1280 + ch); }
#define PO_UNP(w) ((f32x4){bflo(w.x), bfhi(w.x), bflo(w.y), bfhi(w.y)})
#define PO_COMP(t, S) { const f32x4 r0 = PO_UNP(S##rr), r1 = PO_UNP(S##rp), k0 = PO_UNP(S##kr), k1 = PO_UNP(S##kp), v0 = PO_UNP(S##vr), v1 = PO_UNP(S##vp), av = PO_UNP(S##a2), gv = PO_UNP(S##g2), yv = PO_UNP(S##y2); \
                const f32x4 r = r0 + (r1 - r0) * mu_r, k = k0 + (k1 - k0) * mu_k, v = v0 + (v1 - v0) * mu_v; \
                const f32x4 k2 = k * (1.0f + (av - 1.0f) * k_a); const f32x4 rk4 = r * k2 * r_k; \
                const float rk = red16((rk4[0] + rk4[1]) + (rk4[2] + rk4[3])); \
                const float mu = red16((yv[0] + yv[1]) + (yv[2] + yv[3])) * (1.0f / 64.0f); const f32x4 yc = yv - mu; \
                const float var = red16((yc[0] * yc[0] + yc[1] * yc[1]) + (yc[2] * yc[2] + yc[3] * yc[3])) * (1.0f / 64.0f); \
                const float rstd = 1.0f / sqrtf(var + GN_EPS_); const f32x4 o = (yc * rstd * gng + gnb + v * rk) * gv; \
                u32x2 w; w.x = cvt_pk_bf16(o[0], o[1]); w.y = cvt_pk_bf16(o[2], o[3]); *(u32x2*)(YY + (size_t)(t) * LDY_ + ch) = w; }
            for (int t = gw / 5; t < M_; t += 2 * nslot) {
                const int tb = t + nslot; const bool hasb = tb < M_; const int tbc = hasb ? tb : t;
                PO_LOAD(t, A_); PO_LOAD(tbc, B_);
                PO_COMP(t, A_);
                if (hasb) PO_COMP(tb, B_);
            }
#undef PO_LOAD
#undef PO_UNP
#undef PO_COMP
        }
    }
    const bf16_t* Og = (const bf16_t*)(p.ws + WS_O); const float* lse = (const float*)(p.ws + WS_LSE);
    for (int task = bid * 8 + wave; task < M_ * 3; task += G * 8) {
        const int t = task / 3, hg = task % 3, hh = hg * 4 + (lane >> 4), c = hh * 64 + cgp * 4;
        const float l0 = lse[(size_t)t * NHA_ + hh], l1 = lse[(size_t)M_ * NHA_ + (size_t)t * NHA_ + hh], l2 = lse[(size_t)2 * M_ * NHA_ + (size_t)t * NHA_ + hh];
        const float lm = fmaxf(l0, fmaxf(l1, l2)); const float e0 = __expf(l0 - lm), e1 = __expf(l1 - lm), e2 = __expf(l2 - lm); const float inv = 1.0f / (e0 + e1 + e2);
        const u32x2 o0 = *(const u32x2*)(Og + (size_t)t * AD_ + c), o1 = *(const u32x2*)(Og + (size_t)M_ * AD_ + (size_t)t * AD_ + c), o2 = *(const u32x2*)(Og + (size_t)2 * M_ * AD_ + (size_t)t * AD_ + c);
        const f32x4 a0 = {bflo(o0.x), bfhi(o0.x), bflo(o0.y), bfhi(o0.y)}, a1 = {bflo(o1.x), bfhi(o1.x), bflo(o1.y), bfhi(o1.y)}, a2 = {bflo(o2.x), bfhi(o2.x), bflo(o2.y), bfhi(o2.y)};
        const f32x4 o = (a0 * e0 + a1 * e1 + a2 * e2) * inv;
        u32x2 w; w.x = cvt_pk_bf16(o[0], o[1]); w.y = cvt_pk_bf16(o[2], o[3]);
        *(u32x2*)(YY + (size_t)t * LDY_ + RW_ + c) = w;
    }
}

__global__ void __launch_bounds__(512, 2) fwd_kernel(Params p) {
    extern __shared__ __attribute__((aligned(16))) unsigned char lds_raw[];
    cg::grid_group grid = cg::this_grid();
    LAS unsigned char* ldsl = (LAS unsigned char*)lds_raw;
    const int bid = blockIdx.x, G = gridDim.x;
    unsigned char* ws = p.ws;
    const int lo = p.ph_lo, hi = p.ph_hi;
#define IN(k) (lo <= (k) && (k) < hi)
#define GSYNC() do { grid.sync(); } while (0)
#define SEAM(k) do { if (IN(k) && IN((k) + 1)) GSYNC(); } while (0)
    bf16_t* Xb = (bf16_t*)(ws + WS_XB); bf16_t* Hh = (bf16_t*)(ws + WS_H); float* Hf = (float*)(ws + WS_HF);
    bf16_t* Wgu = (bf16_t*)(ws + WS_WGU); bf16_t* Wd = (bf16_t*)(ws + WS_WD);

    if (IN(0)) { phase_convert0(p, lds_raw, bid, G); } SEAM(0);
    if (IN(1)) { pg8::Gemm g{Xb, Wgu, M_, 2 * FF_, D_, D_, D_}; pg8::StaticOrder S; S.init(M_, 2 * FF_, G, bid); EpiSwiGLU E{Hh, FF_}; pg8::gemm_phase(ldsl, g, S, E); } SEAM(1);
    if (IN(2)) { pg8::Gemm g{Hh, Wd, M_, D_, FF_, FF_, FF_}; pg8::StaticOrder S; S.init(M_, D_, G, bid); EpiRes E{p.out, p.in[0], D_, ALPHA_, 0.5f}; pg8::gemm_phase(ldsl, g, S, E); } SEAM(2);
    if (IN(3)) { ln_phase(p.out, p.in[5], p.in[6], Hf, Xb, bid, G); } SEAM(3);
    if (IN(4)) {
        pg8::Gemm g{Xb, (bf16_t*)(ws + WS_WIN), M_, NIN_, D_, D_, D_}; pg8::StaticOrder S; S.init(M_, NIN_, G, bid);
        EpiWin E{ws, (long)((unsigned char*)p.out - ws)};
        pg8::gemm_phase(ldsl, g, S, E);
    } SEAM(4);
    if (IN(5)) { phase_prep(p, lds_raw, bid, G); } SEAM(5);
    if (IN(6)) { lora_phase(p, lds_raw, 0, 2, bid, G); } SEAM(6);
    if (IN(7)) { phase_scan_attn(p, lds_raw, bid, G); } SEAM(7);
    if (IN(8)) { lora_phase(p, lds_raw, 2, 3, bid, G); } SEAM(8);
    if (IN(9)) { phase_post(p, bid, G); } SEAM(9);
    if (IN(10)) { pg8::Gemm g{(bf16_t*)((unsigned char*)p.out + DO_YY), (bf16_t*)(ws + WS_WOUT), M_, D_, D_, LDY_, LDY_}; pg8::StaticOrder S; S.init(M_, D_, G, bid); EpiRes E{(float*)(ws + WS_Z2), Hf, D_, ALPHA_, 1.0f}; pg8::gemm_phase(ldsl, g, S, E); } SEAM(10);
    if (IN(11)) { ln_phase((const float*)(ws + WS_Z2), p.in[25], p.in[26], Hf, Xb, bid, G); convert_ffn_weights(p, 27, 28, 29, (float*)lds_raw, bid, G); } SEAM(11);
    if (IN(12)) { pg8::Gemm g{Xb, Wgu, M_, 2 * FF_, D_, D_, D_}; pg8::StaticOrder S; S.init(M_, 2 * FF_, G, bid); EpiSwiGLU E{Hh, FF_}; pg8::gemm_phase(ldsl, g, S, E); } SEAM(12);
    if (IN(13)) { pg8::Gemm g{Hh, Wd, M_, D_, FF_, FF_, FF_}; pg8::StaticOrder S; S.init(M_, D_, G, bid); EpiRes E{p.out, Hf, D_, ALPHA_, 0.5f}; pg8::gemm_phase(ldsl, g, S, E); } SEAM(13);
    if (IN(14)) { ln_phase(p.out, p.in[30], p.in[31], p.out, nullptr, bid, G); }
#undef IN
#undef SEAM
}

extern "C" void kernel_launch(void* const* d_in, const int* in_sizes, int n_in, void* d_out, int out_size, void* d_ws, size_t ws_size, hipStream_t stream) {
    static int grid_blocks = 0;
    if (grid_blocks == 0) {
        int dev = 0, cus = 0, per_cu = 0;
        hipGetDevice(&dev);
        hipDeviceGetAttribute(&cus, hipDeviceAttributeMultiprocessorCount, dev);
        if (hipFuncSetAttribute((const void*)fwd_kernel, hipFuncAttributeMaxDynamicSharedMemorySize, LDS_BYTES) != hipSuccess) { fprintf(stderr, "hipFuncSetAttribute failed\n"); }
        if (hipOccupancyMaxActiveBlocksPerMultiprocessor(&per_cu, (const void*)fwd_kernel, 512, LDS_BYTES) != hipSuccess || per_cu < 1) { fprintf(stderr, "occupancy query: %d\n", per_cu); per_cu = 1; }
        (void)hipGetLastError();
        grid_blocks = cus * 1;
        if (ws_size < 512 * MiB || n_in != 32) fprintf(stderr, "kernel_launch: unexpected ws_size %zu / n_in %d\n", ws_size, n_in);
    }
    Params p{};
    for (int i = 0; i < 32; ++i) p.in[i] = (const float*)d_in[i];
    p.out = (float*)d_out; p.ws = (unsigned char*)d_ws;
#if N_LAUNCH_MODE == 1
    p.ph_lo = 0; p.ph_hi = NPHASE;
    void* args[] = {&p};
    hipError_t e = hipLaunchCooperativeKernel((const void*)fwd_kernel, dim3(grid_blocks), dim3(512), args, LDS_BYTES, stream);
    if (e != hipSuccess) fprintf(stderr, "cooperative launch failed: %s (grid %d)\n", hipGetErrorString(e), grid_blocks);
#else
    for (int ph = 0; ph < NPHASE; ++ph) {
        p.ph_lo = ph; p.ph_hi = ph + 1;
        void* args[] = {&p};
        hipError_t e = hipLaunchCooperativeKernel((const void*)fwd_kernel, dim3(grid_blocks), dim3(512), args, LDS_BYTES, stream);
        if (e != hipSuccess) { fprintf(stderr, "launch %d failed: %s (grid %d)\n", ph, hipGetErrorString(e), grid_blocks); break; }
    }
#endif
}
```

```cpp
#include <hip/hip_runtime.h>
#include <hip/hip_cooperative_groups.h>
#include <cstdio>
namespace cg = cooperative_groups;

#ifndef N_LAUNCH_MODE
#define N_LAUNCH_MODE 1
#endif

#define LAS __attribute__((address_space(3)))
typedef unsigned short bf16_t;
typedef short bf16x8 __attribute__((ext_vector_type(8)));
typedef float f32x4 __attribute__((ext_vector_type(4)));
typedef float f32x2 __attribute__((ext_vector_type(2)));
typedef unsigned u32x4 __attribute__((ext_vector_type(4)));
typedef unsigned u32x2 __attribute__((ext_vector_type(2)));

constexpr int T_ = 8192, B_ = 2, M_ = B_ * T_, D_ = 2048, FF_ = 5632;
constexpr int RW_ = 1280, NHR_ = 20, NHA_ = 12, AD_ = 768;
constexpr int NIN_ = 6656;
constexpr float ALPHA_ = 1.189207115002721f;
constexpr float LN_EPS_ = 1e-5f, GN_EPS_ = 64e-5f;
constexpr int NPHASE = 15;
constexpr int LDY_ = 2048 + 128;
constexpr int LDS_BYTES = 131072;

constexpr size_t MiB = 1048576ull;
constexpr size_t WS_HF = 0;
constexpr size_t WS_WIN = 128 * MiB;
constexpr size_t WS_WOUT = 154 * MiB;
constexpr size_t WS_WLORA = 290 * MiB + 262144;
constexpr size_t WS_WGU = 164 * MiB;
constexpr size_t WS_WD = 208 * MiB;
constexpr size_t WS_XB = 230 * MiB;
constexpr size_t WS_H = 294 * MiB;
constexpr size_t WS_PRKV = 294 * MiB;
constexpr size_t WS_PLORA = 438 * MiB;
constexpr size_t WS_PV = 470 * MiB;
constexpr size_t WS_XLORA = 414 * MiB;
constexpr size_t WS_LW = 164 * MiB;
constexpr size_t WS_LA = 204 * MiB;
constexpr size_t WS_LG = 164 * MiB;
constexpr size_t WS_Y = 248 * MiB;
constexpr size_t WS_LSE = 288 * MiB;
constexpr size_t WS_O = 438 * MiB;
constexpr size_t WS_Z2 = 294 * MiB;
constexpr size_t DO_PQ = 0, DO_PK = 24 * MiB, DO_VT = 48 * MiB, DO_YY = 0;

struct Params {
    const float* in[32];
    float* out;
    unsigned char* ws;
    int ph_lo, ph_hi;
};

__device__ __forceinline__ bf16_t f2bf(float f) { unsigned u = __float_as_uint(f); u += 0x7FFFu + ((u >> 16) & 1u); return (bf16_t)(u >> 16); }
__device__ __forceinline__ float bf2f(bf16_t b) { return __uint_as_float(((unsigned)b) << 16); }
__device__ __forceinline__ unsigned cvt_pk_bf16(float lo, float hi) { unsigned r; asm("v_cvt_pk_bf16_f32 %0, %1, %2" : "=v"(r) : "v"(lo), "v"(hi)); return r; }
__device__ __forceinline__ float bflo(unsigned w) { return __uint_as_float(w << 16); }
__device__ __forceinline__ float bfhi(unsigned w) { return __uint_as_float(w & 0xffff0000u); }
template <int CTRL> __device__ __forceinline__ float dppf(float x) { return __builtin_bit_cast(float, __builtin_amdgcn_update_dpp(0, __builtin_bit_cast(int, x), CTRL, 0xf, 0xf, false)); }
__device__ __forceinline__ int tidx() { int t = threadIdx.x; asm volatile("" : "+v"(t)); return t; }
__device__ __forceinline__ float red16(float x) {
    x += dppf<0xB1>(x); x += dppf<0x4E>(x); x += dppf<0x141>(x); x += dppf<0x128>(x); return x;
}
__device__ __forceinline__ float wave_sum(float x) {
#pragma unroll
    for (int o = 32; o >= 1; o >>= 1) x += __shfl_xor(x, o);
    return x;
}

namespace pg8 {
constexpr int BM = 256, BK = 64, HALF = 128, HTB = HALF * BK * 2, STAGE_BYTES = 8 * HTB, NXCD = 8, WGM = 8;
__device__ __forceinline__ int lds_byte(int r, int c) { const int st = (r >> 4) * 2 + (c >> 5), rr = r & 15, cc = c & 31, ob = rr * 64 + cc * 2; return st * 1024 + (ob ^ (((ob >> 9) & 1) << 5)); }
__device__ __forceinline__ void stage_rc(int b, int& R, int& C) { const int st = b / 1024, sb = b % 1024, swz = sb ^ (((sb >> 9) & 1) << 5); R = (st >> 1) * 16 + swz / 64; C = (st & 1) * 32 + (swz % 64) / 2; }
__device__ __forceinline__ int perm32(int rho) { const int n = rho >> 4, i = rho & 15; return 8 * (i >> 2) + 4 * n + (i & 3); }
struct Unit { int pm, pn; };
struct Gemm { const bf16_t* A; const bf16_t* Bt; int M, N, K, lda, ldb; };
struct StaticOrder {
    int nM, nN, nwg, G, c;
    __device__ void init(int M, int N, int G_, int c_) { nM = M / BM; nN = N / BM; nwg = nM * nN; G = G_; c = c_; }
    __device__ bool next(int i, Unit& u) const {
        const long L = (long)i * G + c; if (L >= nwg) return false;
        int wgid = (int)L; { const int q = nwg / NXCD, r = nwg % NXCD, xcd = wgid % NXCD, off = wgid / NXCD; wgid = (xcd < r ? xcd * (q + 1) : r * (q + 1) + (xcd - r) * q) + off; }
        const int nig = WGM * nN, gid = wgid / nig, fm = gid * WGM, gsz = (nM - fm) < WGM ? (nM - fm) : WGM;
        u.pm = fm + ((wgid % nig) % gsz); u.pn = (wgid % nig) / gsz; return true;
    }
};

template <class Epi>
__device__ __forceinline__ void gemm_phase(LAS unsigned char* lds, const Gemm g, const StaticOrder& S, const Epi& E) {
    const int tid = tidx(), wid = __builtin_amdgcn_readfirstlane(tid >> 6), lane = tid & 63, wr = wid >> 2, wc = wid & 3, fr = lane & 15, fq = lane >> 4;
    int K = g.K, lda_ = g.lda, ldb_ = g.ldb; asm volatile("" : "+s"(K), "+s"(lda_), "+s"(ldb_));
    const int nt = K / BK;
    unsigned voffA[2], voffB[2];
#pragma unroll
    for (int i = 0; i < 2; ++i) { int R, C; stage_rc(tid * 16 + i * 8192, R, C); const int Rb = Epi::PERM ? ((R & ~31) + perm32(R & 31)) : R;
        voffA[i] = (unsigned)(R * lda_ + C) * 2u; voffB[i] = (unsigned)(Rb * ldb_ + C) * 2u; }
    const size_t kstep = (size_t)(BK * 2);
    const size_t hstepA = (size_t)HALF * lda_ * 2, hstepB = (size_t)HALF * ldb_ * 2;
    const size_t tstepA = 2 * hstepA, tstepB = 2 * hstepB;
    const unsigned ldsw = (unsigned)wid * 1024u;
    const int aoff = lds_byte(wr * 64 + fr, fq * 8), boff = lds_byte(wc * 32 + fr, fq * 8);
#define PG8_SA(b, h) (((b) * 2 + (h)) * HTB)
#define PG8_SB(b, h) ((4 + (b) * 2 + (h)) * HTB)
#define PG8_STAGE(bufoff, gbase, voff) do { _Pragma("unroll") for (int _i = 0; _i < 2; ++_i) \
        __builtin_amdgcn_global_load_lds((const unsigned*)((const char*)(gbase) + (voff)[_i]), (LAS unsigned*)(lds + (bufoff) + ldsw + _i * 8192), 16, 0, 0); } while (0)
#define PG8_LDA(dst, b, h) do { _Pragma("unroll") for (int m = 0; m < 4; ++m) _Pragma("unroll") for (int k = 0; k < 2; ++k) dst[m][k] = *(const LAS bf16x8*)(lds + PG8_SA(b, h) + aoff + m * 2048 + k * 1024); } while (0)
#define PG8_LDB(dst, b, h) do { _Pragma("unroll") for (int n = 0; n < 2; ++n) _Pragma("unroll") for (int k = 0; k < 2; ++k) dst[n][k] = *(const LAS bf16x8*)(lds + PG8_SB(b, h) + boff + n * 2048 + k * 1024); } while (0)
#define PG8_MMA(ai, bj, At, Bt) do { __builtin_amdgcn_s_setprio(1); _Pragma("unroll") for (int m = 0; m < 4; ++m) _Pragma("unroll") for (int n = 0; n < 2; ++n) _Pragma("unroll") for (int k = 0; k < 2; ++k) \
        acc[ai][bj][m][n] = __builtin_amdgcn_mfma_f32_16x16x32_bf16(Bt[n][k], At[m][k], acc[ai][bj][m][n], 0, 0, 0); __builtin_amdgcn_s_setprio(0); } while (0)
#define PG8_WAIT_V(n) asm volatile("s_waitcnt vmcnt(" #n ")" ::: "memory")
#define PG8_WAIT_L(n) asm volatile("s_waitcnt lgkmcnt(" #n ")" ::: "memory")
#define PG8_BAR __builtin_amdgcn_s_barrier()
#define PG8_SCHED __builtin_amdgcn_sched_barrier(0)
    Unit cur, nxt; int ui = 0;
    if (!S.next(0, cur)) return;
    f32x4 acc[2][2][4][2];
#pragma unroll
    for (int a = 0; a < 2; ++a)
#pragma unroll
        for (int b = 0; b < 2; ++b)
#pragma unroll
            for (int m = 0; m < 4; ++m)
#pragma unroll
                for (int n = 0; n < 2; ++n) acc[a][b][m][n] = (f32x4){0.f, 0.f, 0.f, 0.f};
    bf16x8 At[4][2], B0[2][2], B1[2][2];
    const char* cA = (const char*)g.A + (size_t)cur.pm * tstepA; const char* cB = (const char*)g.Bt + (size_t)cur.pn * tstepB;
    PG8_STAGE(PG8_SB(0, 0), cB, voffB); PG8_STAGE(PG8_SA(0, 0), cA, voffA); PG8_STAGE(PG8_SB(0, 1), cB + hstepB, voffB); PG8_STAGE(PG8_SA(0, 1), cA + hstepA, voffA);
    if (wr == 1) PG8_BAR;
    PG8_WAIT_V(4); PG8_BAR;
    PG8_STAGE(PG8_SB(1, 0), cB + kstep, voffB); PG8_STAGE(PG8_SA(1, 0), cA + kstep, voffA); PG8_STAGE(PG8_SB(1, 1), cB + hstepB + kstep, voffB);
    PG8_WAIT_V(6); PG8_BAR;
    for (;;) {
        const bool has_next = S.next(ui + 1, nxt);
        const char* nA = has_next ? (const char*)g.A + (size_t)nxt.pm * tstepA : cA; const char* nB = has_next ? (const char*)g.Bt + (size_t)nxt.pn * tstepB : cB;
        for (int t = 0; t < nt; t += 2) {
            const bool last = (t == nt - 2);
            const char* a1 = cA + (size_t)(t + 1) * kstep;
            const char* a2 = last ? nA : cA + (size_t)(t + 2) * kstep; const char* b2 = last ? nB : cB + (size_t)(t + 2) * kstep;
            const char* a3 = a2 + kstep; const char* b3 = b2 + kstep;
            PG8_LDB(B0, 0, 0); PG8_SCHED; PG8_LDA(At, 0, 0); PG8_STAGE(PG8_SA(1, 1), a1 + hstepA, voffA);
            PG8_WAIT_L(8); PG8_BAR; PG8_WAIT_L(0); PG8_MMA(0, 0, At, B0); PG8_BAR; PG8_SCHED;
            PG8_LDB(B1, 0, 1); PG8_STAGE(PG8_SB(0, 0), b2, voffB);
            PG8_BAR; PG8_WAIT_L(0); PG8_MMA(0, 1, At, B1); PG8_BAR;
            PG8_LDA(At, 0, 1); PG8_STAGE(PG8_SA(0, 0), a2, voffA);
            PG8_BAR; PG8_WAIT_L(0); PG8_MMA(1, 0, At, B0); PG8_BAR; PG8_SCHED;
            PG8_STAGE(PG8_SB(0, 1), b2 + hstepB, voffB);
            PG8_WAIT_V(6); PG8_BAR; PG8_MMA(1, 1, At, B1); PG8_BAR;
            PG8_LDB(B0, 1, 0); PG8_SCHED; PG8_LDA(At, 1, 0); PG8_STAGE(PG8_SA(0, 1), a2 + hstepA, voffA);
            PG8_WAIT_L(8); PG8_BAR; PG8_WAIT_L(0); PG8_MMA(0, 0, At, B0); PG8_BAR; PG8_SCHED;
            PG8_LDB(B1, 1, 1); PG8_STAGE(PG8_SB(1, 0), b3, voffB);
            PG8_BAR; PG8_WAIT_L(0); PG8_MMA(0, 1, At, B1); PG8_BAR;
            PG8_LDA(At, 1, 1); PG8_STAGE(PG8_SA(1, 0), a3, voffA);
            PG8_BAR; PG8_WAIT_L(0); PG8_MMA(1, 0, At, B0); PG8_BAR; PG8_SCHED;
            PG8_STAGE(PG8_SB(1, 1), b3 + hstepB, voffB);
            PG8_WAIT_V(6); PG8_BAR; PG8_MMA(1, 1, At, B1); PG8_BAR;
        }
        E(acc, cur, wr, wc, fr, fq);
        if (!has_next) break;
#pragma unroll
        for (int a = 0; a < 2; ++a)
#pragma unroll
            for (int b = 0; b < 2; ++b)
#pragma unroll
                for (int m = 0; m < 4; ++m)
#pragma unroll
                    for (int n = 0; n < 2; ++n) acc[a][b][m][n] = (f32x4){0.f, 0.f, 0.f, 0.f};
        cur = nxt; cA = nA; cB = nB; ++ui;
    }
    PG8_WAIT_V(0);
    if (wr == 0) PG8_BAR;
    PG8_BAR;
#undef PG8_SA
#undef PG8_SB
#undef PG8_STAGE
#undef PG8_LDA
#undef PG8_LDB
#undef PG8_MMA
#undef PG8_WAIT_V
#undef PG8_WAIT_L
#undef PG8_BAR
#undef PG8_SCHED
}
}

typedef f32x4 AccT[2][2][4][2];

__device__ __forceinline__ float silu_f(float x) { return x * __builtin_amdgcn_rcpf(1.0f + __expf(-x)); }

struct EpiSwiGLU {
    static constexpr bool PERM = true;
    bf16_t* H; int ldc;
    __device__ __forceinline__ void operator()(const AccT& acc, const pg8::Unit& u, int wr, int wc, int fr, int fq) const {
        asm volatile("" : "+v"(fr), "+v"(fq));
        const int row0 = u.pm * 256 + wr * 64 + fr, col0 = u.pn * 128 + wc * 32 + 8 * fq;
#pragma unroll
        for (int ai = 0; ai < 2; ++ai)
#pragma unroll
            for (int m = 0; m < 4; ++m) {
                bf16_t* rowp = H + (size_t)(row0 + ai * 128 + m * 16) * ldc + col0;
                const f32x4 g0 = acc[ai][0][m][0], g1 = acc[ai][0][m][1], u0 = acc[ai][1][m][0], u1 = acc[ai][1][m][1];
                u32x4 w;
                w.x = cvt_pk_bf16(silu_f(g0[0]) * u0[0], silu_f(g0[1]) * u0[1]); w.y = cvt_pk_bf16(silu_f(g0[2]) * u0[2], silu_f(g0[3]) * u0[3]);
                w.z = cvt_pk_bf16(silu_f(g1[0]) * u1[0], silu_f(g1[1]) * u1[1]); w.w = cvt_pk_bf16(silu_f(g1[2]) * u1[2], silu_f(g1[3]) * u1[3]);
                *(u32x4*)rowp = w;
            }
    }
};
struct EpiRes {
    static constexpr bool PERM = false;
    float* Z; const float* res; int ldc; float alpha, scale;
    __device__ __forceinline__ void operator()(const AccT& acc, const pg8::Unit& u, int wr, int wc, int fr, int fq) const {
        asm volatile("" : "+v"(fr), "+v"(fq));
        const int row0 = u.pm * 256 + wr * 64 + fr, col0 = u.pn * 256 + wc * 32 + 4 * fq;
#pragma unroll
        for (int ai = 0; ai < 2; ++ai)
#pragma unroll
            for (int m = 0; m < 4; ++m) {
                const size_t off = (size_t)(row0 + ai * 128 + m * 16) * ldc + col0;
#pragma unroll
                for (int bj = 0; bj < 2; ++bj)
#pragma unroll
                    for (int n = 0; n < 2; ++n) {
                        const f32x4 r = *(const f32x4*)(res + off + bj * 128 + n * 16);
                        *(f32x4*)(Z + off + bj * 128 + n * 16) = r * alpha + acc[ai][bj][m][n] * scale;
                    }
            }
    }
};
struct EpiWin {
    static constexpr bool PERM = true;
    unsigned char* ws; long delta;
    __device__ __forceinline__ void operator()(const AccT& acc, const pg8::Unit& u, int wr, int wc, int fr, int fq) const {
        asm volatile("" : "+v"(fr), "+v"(fq));
        const int row0 = u.pm * 256 + wr * 64 + fr, cl = wc * 32 + 8 * fq;
        if (u.pn == 15 || u.pn == 16) {
            const int colt = (u.pn - 15) * 256 + cl;
            float* Plora = (float*)(ws + WS_PLORA);
#pragma unroll
            for (int ai = 0; ai < 2; ++ai)
#pragma unroll
                for (int m = 0; m < 4; ++m) {
                    float* rowp = Plora + (size_t)(row0 + ai * 128 + m * 16) * 512 + colt;
#pragma unroll
                    for (int bj = 0; bj < 2; ++bj)
#pragma unroll
                        for (int n = 0; n < 2; ++n) *(f32x4*)(rowp + bj * 128 + n * 4) = acc[ai][bj][m][n];
                }
        } else {
            size_t boff; int ldc, colt; bool inws = true;
            if (u.pn < 15) { boff = WS_PRKV; ldc = 3840; colt = u.pn * 256; }
            else { const int t = (u.pn - 17) / 3; inws = (t == 2); boff = (t == 0) ? DO_PQ : (t == 1 ? DO_PK : WS_PV); ldc = 768; colt = ((u.pn - 17) % 3) * 256; }
            bf16_t* base = (bf16_t*)(ws + (long)boff + (inws ? 0l : delta));
#pragma unroll
            for (int ai = 0; ai < 2; ++ai)
#pragma unroll
                for (int m = 0; m < 4; ++m) {
                    bf16_t* rowp = base + (size_t)(row0 + ai * 128 + m * 16) * ldc + colt + cl;
#pragma unroll
                    for (int bj = 0; bj < 2; ++bj) {
                        const f32x4 v0 = acc[ai][bj][m][0], v1 = acc[ai][bj][m][1];
                        u32x4 w; w.x = cvt_pk_bf16(v0[0], v0[1]); w.y = cvt_pk_bf16(v0[2], v0[3]); w.z = cvt_pk_bf16(v1[0], v1[1]); w.w = cvt_pk_bf16(v1[2], v1[3]);
                        *(u32x4*)(rowp + bj * 128) = w;
                    }
                }
        }
    }
};
__device__ __forceinline__ int map_row(int n, int mode) {
    if (mode == 1) return (n >> 7) * 256 + (n & 127);
    if (mode == 2) return (n >> 7) * 256 + 128 + (n & 127);
    if (mode == 3) return n < 4288 ? n : n + 64;
    return n;
}
__device__ void convert_weight(const float* __restrict__ W, int K, int N, bf16_t* __restrict__ Wt, int ldk, int mode, float* tile, int bid, int G) {
    const int tid = tidx(), kr = tid >> 4, nc = (tid & 15) * 4, kp = tid & 31, nr = tid >> 5;
    const int tn_n = N / 64, tn_k = K / 64, ntile = tn_n * tn_k;
    int t = bid; if (t >= ntile) return;
    f32x4 v0, v1;
    { const int tk = t / tn_n, tn = t % tn_n; const float* src = W + (size_t)(tk * 64 + kr) * N + tn * 64 + nc; v0 = *(const f32x4*)src; v1 = *(const f32x4*)(src + (size_t)32 * N); }
    while (t < ntile) {
        const int tk = t / tn_n, tn = t % tn_n, tnext = t + G;
        const f32x4 c0 = v0, c1 = v1;
        if (tnext < ntile) { const int tk2 = tnext / tn_n, tn2 = tnext % tn_n; const float* src = W + (size_t)(tk2 * 64 + kr) * N + tn2 * 64 + nc; v0 = *(const f32x4*)src; v1 = *(const f32x4*)(src + (size_t)32 * N); }
#pragma unroll
        for (int j = 0; j < 4; ++j) { tile[kr * 65 + nc + j] = c0[j]; tile[(32 + kr) * 65 + nc + j] = c1[j]; }
        __syncthreads();
        const int drow0 = map_row(tn * 64, mode);
#pragma unroll
        for (int i = 0; i < 4; ++i) { const int n = nr + 16 * i; const float a = tile[(2 * kp) * 65 + n], bq = tile[(2 * kp + 1) * 65 + n];
            *(unsigned*)(Wt + (size_t)(drow0 + n) * ldk + tk * 64 + 2 * kp) = cvt_pk_bf16(a, bq); }
        __syncthreads();
        t = tnext;
    }
}
__device__ void convert_ffn_weights(const Params& p, int ig, int iu, int idn, float* tile, int bid, int G, bool with_down) {
    bf16_t* Wgu = (bf16_t*)(p.ws + WS_WGU); bf16_t* Wd = (bf16_t*)(p.ws + WS_WD);
    convert_weight(p.in[ig], D_, FF_, Wgu, D_, 1, tile, bid, G);
    convert_weight(p.in[iu], D_, FF_, Wgu, D_, 2, tile, (bid + 85) % G, G);
    if (with_down) convert_weight(p.in[idn], FF_, D_, Wd, FF_, 0, tile, (bid + 170) % G, G);
}

__device__ void ln_phase(const float* __restrict__ Z, const float* __restrict__ gam, const float* __restrict__ bet, float* outf, bf16_t* outb, int bid, int G) {
    const int tid = tidx(), wave = tid >> 6, lane = tid & 63;
    f32x4 gv[8], bv[8];
#pragma unroll
    for (int i = 0; i < 8; ++i) { gv[i] = *(const f32x4*)(gam + i * 256 + lane * 4); bv[i] = *(const f32x4*)(bet + i * 256 + lane * 4); }
    for (int row = bid * 8 + wave; row < M_; row += G * 8) {
        const float* zr = Z + (size_t)row * D_;
        f32x4 x[8]; float s = 0.f;
#pragma unroll
        for (int i = 0; i < 8; ++i) { x[i] = *(const f32x4*)(zr + i * 256 + lane * 4); s += (x[i][0] + x[i][1]) + (x[i][2] + x[i][3]); }
        s = wave_sum(s); const float mean = s * (1.0f / D_);
        float q = 0.f;
#pragma unroll
        for (int i = 0; i < 8; ++i) { x[i] = x[i] - mean; q += (x[i][0] * x[i][0] + x[i][1] * x[i][1]) + (x[i][2] * x[i][2] + x[i][3] * x[i][3]); }
        q = wave_sum(q); const float rstd = 1.0f / sqrtf(q * (1.0f / D_) + LN_EPS_);
#pragma unroll
        for (int i = 0; i < 8; ++i) {
            const f32x4 o = x[i] * rstd * gv[i] + bv[i];
            if (outf) *(f32x4*)(outf + (size_t)row * D_ + i * 256 + lane * 4) = o;
            if (outb) { u32x2 w; w.x = cvt_pk_bf16(o[0], o[1]); w.y = cvt_pk_bf16(o[2], o[3]); *(u32x2*)(outb + (size_t)row * D_ + i * 256 + lane * 4) = w; }
        }
    }
}

__device__ void phase_convert0(const Params& p, unsigned char* lds, int bid, int G) {
    float* tile = (float*)lds;
    const int tid = tidx();
    convert_ffn_weights(p, 2, 3, 4, tile, bid, G, true);
    convert_weight(p.in[7], D_, 6592, (bf16_t*)(p.ws + WS_WIN), D_, 3, tile, bid, G);
    { unsigned* z = (unsigned*)((bf16_t*)(p.ws + WS_WIN) + (size_t)4288 * D_); for (int i = bid * 512 + tid; i < 64 * D_ / 2; i += G * 512) z[i] = 0u; }
    { const f32x4* x4 = (const f32x4*)p.in[0]; u32x2* o = (u32x2*)(p.ws + WS_XB);
      for (int i = bid * 512 + tid; i < M_ * D_ / 4; i += G * 512) { const f32x4 v = x4[i]; u32x2 w; w.x = cvt_pk_bf16(v[0], v[1]); w.y = cvt_pk_bf16(v[2], v[3]); o[i] = w; } }
}

__device__ void phase_prep(const Params& p, unsigned char* lds, int bid, int G) {
    const int tid = tidx();
    {
        bf16_t* WL = (bf16_t*)(p.ws + WS_WLORA);
        const float* s0 = p.in[15]; const float* s1 = p.in[17]; const float* s2 = p.in[18];
        for (int i = bid * 512 + tid; i < 1280 * 256; i += G * 512) {
            const int n = i >> 8, k = i & 255;
            WL[i] = (k < 96) ? f2bf(s0[(size_t)k * 1280 + n]) : (bf16_t)0;
            WL[1280 * 256 + i] = (k < 96) ? f2bf(s1[(size_t)k * 1280 + n]) : (bf16_t)0;
            WL[2 * 1280 * 256 + i] = f2bf(s2[(size_t)k * 1280 + n]);
        }
    }
    {
        const float* PL = (const float*)(p.ws + WS_PLORA); bf16_t* XL = (bf16_t*)(p.ws + WS_XLORA);
        const float* mu_w = p.in[11]; const float* mu_a = p.in[12]; const float* mu_g = p.in[13];
        for (int i = bid * 512 + tid; i < M_ * 768; i += G * 512) {
            const int t = i / 768, c = i % 768; float o = 0.f;
            int src = -1; float mu = 0.f; int kind = 0;
            if (c < 96) { src = c; mu = mu_w[c]; kind = 0; }
            else if (c >= 256 && c < 352) { src = 96 + (c - 256); mu = mu_a[c - 256]; kind = 1; }
            else if (c >= 512) { src = 192 + (c - 512); mu = mu_g[c - 512]; kind = 2; }
            if (src >= 0) {
                const float z = PL[(size_t)t * 512 + src]; const float zp = (t % T_) ? PL[(size_t)(t - 1) * 512 + src] : 0.f;
                const float s = z + (zp - z) * mu;
                o = (kind == 0) ? tanhf(s) : (kind == 1 ? s : 1.0f / (1.0f + expf(-s)));
            }
            XL[i] = f2bf(o);
        }
    }
    {
        bf16_t* Pq = (bf16_t*)((unsigned char*)p.out + DO_PQ); bf16_t* Pk = (bf16_t*)((unsigned char*)p.out + DO_PK);
        const int* pos = (const int*)p.in[1];
        for (int i = bid * 512 + tid; i < M_ * 2 * NHA_ * 8; i += G * 512) {
            const int j = i & 7, hh = (i >> 3) % NHA_, qk = (i / (8 * NHA_)) & 1, t = i / (16 * NHA_);
            bf16_t* P = (qk ? Pk : Pq) + (size_t)t * AD_ + hh * 64;
            const float invf = exp2f(-(float)j * 2.3664460711655217f);
            const float ang = (float)pos[t] * invf; const double rv = (double)ang * 0.15915494309189535; const float rev = (float)(rv - rint(rv));
            const float sn = __builtin_amdgcn_sinf(rev), cs = __builtin_amdgcn_cosf(rev);
            const float x1 = bf2f(P[j]), x2 = bf2f(P[8 + j]);
            P[j] = f2bf(x1 * cs - x2 * sn); P[8 + j] = f2bf(x2 * cs + x1 * sn);
        }
    }
    {
        const bf16_t* Pv = (const bf16_t*)(p.ws + WS_PV); bf16_t* VT = (bf16_t*)((unsigned char*)p.out + DO_VT);
        bf16_t* tl = (bf16_t*)lds;
        for (int job = bid; job < (M_ / 256) * NHA_; job += G) {
            const int hh = job % NHA_, tb = job / NHA_, tok0 = tb * 256, b = tok0 / T_, t0 = tok0 % T_;
            __syncthreads();
            for (int i = tid; i < 256 * 32; i += 512) { const int tr = i >> 5, cp = i & 31; *(unsigned*)(tl + tr * 66 + cp * 2) = *(const unsigned*)(Pv + (size_t)(tok0 + tr) * AD_ + hh * 64 + cp * 2); }
            __syncthreads();
#pragma unroll
            for (int g = 0; g < 3; ++g) {
                const int sh = 2 * g, d = 1 << sh, per = 256 >> sh;
                bf16_t* dst = VT + (size_t)g * M_ * AD_ + ((size_t)(b * NHA_ + hh) * 64) * T_;
                for (int o = tid; o < 64 * 256; o += 512) {
                    const int e = o >> 8, j = o & 255, r = j / per, q = j % per, tloc = q * d + r;
                    dst[(size_t)e * T_ + r * (T_ >> sh) + (t0 >> sh) + q] = tl[tloc * 66 + e];
                }
            }
        }
        __syncthreads();
    }
}

__device__ __forceinline__ float lora_act(int which, float x, float c) {
    if (which == 0) { const float z = -(c + x); const float sp = fmaxf(z, 0.f) + __logf(1.0f + __expf(-fabsf(z))); return __expf(-sp - 0.5f); }
    if (which == 1) return __builtin_amdgcn_rcpf(1.0f + __expf(-(c + x)));
    return x;
}
__device__ void lora_phase(const Params& p, unsigned char* lds, int wlo, int whi, int bid, int G) {
    const int tid = tidx(), wave = tid >> 6, lane = tid & 63, rl = lane & 15, gq = lane >> 4;
    const bf16_t* XL = (const bf16_t*)(p.ws + WS_XLORA); const bf16_t* WL = (const bf16_t*)(p.ws + WS_WLORA);
    unsigned char* Ash = lds;
    unsigned char* Bsh = lds + 128 * 528;
    asm volatile("" : "+s"(wlo), "+s"(whi));
    const int nw = whi - wlo, nitem = 128 * nw * 2;
    for (int item = bid; item < nitem; item += G) {
        const int half = item & 1, which = wlo + (item >> 1) % nw, rb = (item >> 1) / nw;
        const int K = (which == 2) ? 256 : 128, koff = which * 256, cpr = K / 8;
        bf16_t* Ob = (bf16_t*)(p.ws + (which == 0 ? WS_LW : (which == 1 ? WS_LA : WS_LG)));
        const float* cvec = (which == 0) ? p.in[14] : p.in[16];
        __syncthreads();
        for (int c = tid; c < 128 * cpr; c += 512) { const int r = c / cpr, ck = c % cpr; *(u32x4*)(Ash + r * 528 + ck * 16) = *(const u32x4*)(XL + (size_t)(rb * 128 + r) * 768 + koff + ck * 8); }
        const int nbc = (64 * cpr) / 512;
        u32x4 breg[4];
#pragma unroll
        for (int j = 0; j < 4; ++j) if (j < nbc) { const int c = tid + 512 * j, r = c / cpr, ck = c % cpr; breg[j] = *(const u32x4*)(WL + (size_t)which * 1280 * 256 + (size_t)(half * 640 + r) * 256 + ck * 8); }
        for (int cb = 0; cb < 10; ++cb) {
            const int col0 = (half * 10 + cb) * 64;
            __syncthreads();
#pragma unroll
            for (int j = 0; j < 4; ++j) if (j < nbc) { const int c = tid + 512 * j, r = c / cpr, ck = c % cpr; *(u32x4*)(Bsh + r * 528 + ck * 16) = breg[j]; }
            __syncthreads();
            if (cb + 1 < 10) {
#pragma unroll
                for (int j = 0; j < 4; ++j) if (j < nbc) { const int c = tid + 512 * j, r = c / cpr, ck = c % cpr; breg[j] = *(const u32x4*)(WL + (size_t)which * 1280 * 256 + (size_t)(col0 + 64 + r) * 256 + ck * 8); }
            }
            f32x4 acc[4];
#pragma unroll
            for (int nt = 0; nt < 4; ++nt) acc[nt] = (f32x4){0.f, 0.f, 0.f, 0.f};
            for (int ks = 0; ks < K / 32; ++ks) {
                const bf16x8 Af = *(const bf16x8*)(Ash + (16 * wave + rl) * 528 + ks * 64 + gq * 16);
#pragma unroll
                for (int nt = 0; nt < 4; ++nt) { const bf16x8 Bf = *(const bf16x8*)(Bsh + (16 * nt + rl) * 528 + ks * 64 + gq * 16); acc[nt] = __builtin_amdgcn_mfma_f32_16x16x32_bf16(Bf, Af, acc[nt], 0, 0, 0); }
            }
            const size_t row = (size_t)rb * 128 + 16 * wave + rl;
#pragma unroll
            for (int nt = 0; nt < 4; ++nt) {
                const int col = col0 + 16 * nt + 4 * gq; f32x4 cv = {0.f, 0.f, 0.f, 0.f};
                if (which != 2) cv = *(const f32x4*)(cvec + col);
                u32x2 w; w.x = cvt_pk_bf16(lora_act(which, acc[nt][0], cv[0]), lora_act(which, acc[nt][1], cv[1])); w.y = cvt_pk_bf16(lora_act(which, acc[nt][2], cv[2]), lora_act(which, acc[nt][3], cv[3]));
                *(u32x2*)(Ob + row * RW_ + col) = w;
            }
        }
    }
    __syncthreads();
}

__device__ void scan_unit(const Params& p, unsigned char* lds, int bh, int qd) {
    const int tid = tidx(), wave = tid >> 6, lane = tid & 63;
    const int b = bh / NHR_, h = bh % NHR_;
    float* bufX = (float*)lds;
    float* bufV = (float*)(lds + 81920);
    float* bufY = (float*)(lds + 81920 + 4096);
    const bf16_t* Prkv = (const bf16_t*)(p.ws + WS_PRKV); const bf16_t* Lw = (const bf16_t*)(p.ws + WS_LW); const bf16_t* La = (const bf16_t*)(p.ws + WS_LA);
    bf16_t* Y = (bf16_t*)(p.ws + WS_Y);
    const bool loader = wave >= 4;
    const int ts = lane >> 4, cg = lane & 15, ch = h * 64 + cg * 4;
    f32x4 mu_r = {0, 0, 0, 0}, mu_k = mu_r, mu_v = mu_r, k_k = mu_r, k_a = mu_r;
    if (loader) { mu_r = *(const f32x4*)(p.in[8] + ch); mu_k = *(const f32x4*)(p.in[9] + ch); mu_v = *(const f32x4*)(p.in[10] + ch); k_k = *(const f32x4*)(p.in[19] + ch); k_a = *(const f32x4*)(p.in[20] + ch); }
    const int lw = wave - 4;
    f32x4 S = {0.f, 0.f, 0.f, 0.f};
    const int rowl = 4 * (wave & 3) + (lane >> 4);

    struct LReg { u32x2 rr, kr, vr, rp, kp, vp, ew, av; };
#define SC_ISSUE(cc, R, gi) { const int tl_ = 4 * (lw + 4 * (gi)) + ts, tseq_ = (cc) * 32 + tl_; const size_t tok_ = (size_t)b * T_ + tseq_; const bf16_t* pr_ = Prkv + tok_ * 3840 + ch; \
        R.rr = *(const u32x2*)pr_; R.kr = *(const u32x2*)(pr_ + 1280); R.vr = *(const u32x2*)(pr_ + 2560); \
        R.rp = (u32x2){0u, 0u}; R.kp = R.rp; R.vp = R.rp; \
        if (tseq_ > 0) { R.rp = *(const u32x2*)(pr_ - 3840); R.kp = *(const u32x2*)(pr_ - 3840 + 1280); R.vp = *(const u32x2*)(pr_ - 3840 + 2560); } \
        R.ew = *(const u32x2*)(Lw + tok_ * 1280 + ch); R.av = *(const u32x2*)(La + tok_ * 1280 + ch); }
#define SC_PROC(buf_, R, gi) { const int tl_ = 4 * (lw + 4 * (gi)) + ts; \
        const f32x4 r0 = {bflo(R.rr.x), bfhi(R.rr.x), bflo(R.rr.y), bfhi(R.rr.y)}, r1 = {bflo(R.rp.x), bfhi(R.rp.x), bflo(R.rp.y), bfhi(R.rp.y)}; \
        const f32x4 k0 = {bflo(R.kr.x), bfhi(R.kr.x), bflo(R.kr.y), bfhi(R.kr.y)}, k1 = {bflo(R.kp.x), bfhi(R.kp.x), bflo(R.kp.y), bfhi(R.kp.y)}; \
        const f32x4 v0 = {bflo(R.vr.x), bfhi(R.vr.x), bflo(R.vr.y), bfhi(R.vr.y)}, v1 = {bflo(R.vp.x), bfhi(R.vp.x), bflo(R.vp.y), bfhi(R.vp.y)}; \
        const f32x4 ew = {bflo(R.ew.x), bfhi(R.ew.x), bflo(R.ew.y), bfhi(R.ew.y)}, av = {bflo(R.av.x), bfhi(R.av.x), bflo(R.av.y), bfhi(R.av.y)}; \
        const f32x4 r = r0 + (r1 - r0) * mu_r, k = k0 + (k1 - k0) * mu_k, v = v0 + (v1 - v0) * mu_v; \
        f32x4 dec; dec[0] = __builtin_amdgcn_exp2f(ew[0] * -1.4426950408889634f); dec[1] = __builtin_amdgcn_exp2f(ew[1] * -1.4426950408889634f); dec[2] = __builtin_amdgcn_exp2f(ew[2] * -1.4426950408889634f); dec[3] = __builtin_amdgcn_exp2f(ew[3] * -1.4426950408889634f); \
        const f32x4 kku = k * k_k; float s1 = (kku[0] * kku[0] + kku[1] * kku[1]) + (kku[2] * kku[2] + kku[3] * kku[3]); s1 = red16(s1); \
        const float rn = 1.0f / fmaxf(sqrtf(s1), 1e-12f); const f32x4 kk = kku * rn; const f32x4 k2 = k * (1.0f + (av - 1.0f) * k_a); \
        float* X = bufX + ((size_t)((buf_) * 32 + tl_)) * 320 + cg * 4; \
        *(f32x4*)(X) = dec; *(f32x4*)(X + 64) = -kk; *(f32x4*)(X + 128) = kk * av; *(f32x4*)(X + 192) = k2; *(f32x4*)(X + 256) = r; \
        if ((cg >> 2) == qd) *(f32x4*)(bufV + ((buf_) * 32 + tl_) * 16 + (cg & 3) * 4) = v; }
    LReg A0, A1, B0, B1;
    auto store_y = [&](int c, int buf) {
        const int lt = tid - 256, tl = lt >> 3, pr = lt & 7;
        const float y0 = bufY[(buf * 32 + tl) * 16 + 2 * pr], y1 = bufY[(buf * 32 + tl) * 16 + 2 * pr + 1];
        *(unsigned*)(Y + ((size_t)b * T_ + c * 32 + tl) * 1280 + h * 64 + 16 * qd + 2 * pr) = cvt_pk_bf16(y0, y1);
    };

    __syncthreads();
    if (loader) { SC_ISSUE(0, A0, 0); SC_ISSUE(0, A1, 1); SC_PROC(0, A0, 0); SC_PROC(0, A1, 1); SC_ISSUE(1, A0, 0); SC_ISSUE(1, A1, 1); }
    __syncthreads();
    for (int c = 0; c < T_ / 32; ++c) {
        const int buf = c & 1;
        if (!loader) {
            const float* Xc = bufX + (size_t)(buf * 32) * 320 + cg * 4;
            const float* Vc = bufV + (buf * 32) * 16 + rowl;
#define SC_LD(i, W, A, B, K, R, V) { const float* X_ = Xc + (i) * 320; W = *(const f32x4*)X_; A = *(const f32x4*)(X_ + 64); B = *(const f32x4*)(X_ + 128); K = *(const f32x4*)(X_ + 192); R = *(const f32x4*)(X_ + 256); V = Vc[(i) * 16]; }
#define SC_STEP(tt, W, A, B, K, R, V) { \
                f32x2 pa_ = (f32x2){S[0], S[1]} * (f32x2){A[0], A[1]}; pa_ = __builtin_elementwise_fma((f32x2){S[2], S[3]}, (f32x2){A[2], A[3]}, pa_); float sa = pa_.x + pa_.y; sa = red16(sa); \
                S = S * W + B * sa + K * V; \
                f32x2 py_ = (f32x2){S[0], S[1]} * (f32x2){R[0], R[1]}; py_ = __builtin_elementwise_fma((f32x2){S[2], S[3]}, (f32x2){R[2], R[3]}, py_); float y = py_.x + py_.y; y = red16(y); \
                ykeep = (cg == ((tt) & 15)) ? y : ykeep; \
                if (((tt) & 15) == 15) bufY[(buf * 32 + ((tt) - 15) + cg) * 16 + rowl] = ykeep; }
            f32x4 w0, a0, b0, k0, r0, w1, a1, b1, k1, r1, w2, a2, b2, k2, r2, w3, a3, b3, k3, r3; float v0, v1, v2, v3; float ykeep = 0.f;
            SC_LD(0, w0, a0, b0, k0, r0, v0); SC_LD(1, w1, a1, b1, k1, r1, v1);
#pragma unroll
            for (int t = 0; t < 32; t += 2) {
                SC_LD((t + 2 < 32 ? t + 2 : 31), w2, a2, b2, k2, r2, v2);
                SC_STEP(t, w0, a0, b0, k0, r0, v0);
                SC_LD((t + 3 < 32 ? t + 3 : 31), w3, a3, b3, k3, r3, v3);
                SC_STEP(t + 1, w1, a1, b1, k1, r1, v1);
                w0 = w2; a0 = a2; b0 = b2; k0 = k2; r0 = r2; v0 = v2; w1 = w3; a1 = a3; b1 = b3; k1 = k3; r1 = r3; v1 = v3;
            }
#undef SC_LD
#undef SC_STEP
        } else {
            { const int c2 = (c + 2 < T_ / 32) ? c + 2 : T_ / 32 - 1; SC_ISSUE(c2, B0, 0); SC_ISSUE(c2, B1, 1); }
            if (c + 1 < T_ / 32) { SC_PROC(buf ^ 1, A0, 0); SC_PROC(buf ^ 1, A1, 1); }
            if (c > 0) store_y(c - 1, buf ^ 1);
            A0 = B0; A1 = B1;
        }
        __syncthreads();
    }
    if (loader) store_y(T_ / 32 - 1, 1);
    __syncthreads();
}

__device__ void attn_item(const Params& p, unsigned char* lds, int item) {
    const int tid = tidx(), wave = tid >> 6, lane = tid & 63, qn = lane & 15, gq = lane >> 4;
    const int g = item / 1536, rem = item % 1536, b = rem / 768, hh = (rem >> 6) % NHA_, rn = rem & 63;
    const int sh = 2 * g, d = 1 << sh, L = T_ >> sh, nb = 64 >> sh, r = rn / nb, n = rn % nb;
    const bf16_t* Pq = (const bf16_t*)((unsigned char*)p.out + DO_PQ); const bf16_t* Pk = (const bf16_t*)((unsigned char*)p.out + DO_PK);
    const bf16_t* VT = (const bf16_t*)((unsigned char*)p.out + DO_VT) + (size_t)g * M_ * AD_ + ((size_t)(b * NHA_ + hh) * 64) * T_;
    bf16_t* Og = (bf16_t*)(p.ws + WS_O) + (size_t)g * M_ * AD_; float* lse = (float*)(p.ws + WS_LSE) + (size_t)g * M_ * NHA_;
    unsigned char* Ksh = lds;
    unsigned char* Vsh = lds + 256 * 144;
    __syncthreads();
#pragma unroll
    for (int i = 0; i < 4; ++i) {
        const int chunk = tid + 512 * i, kap = chunk >> 3, part = chunk & 7;
        const int lp = 128 * (n - 1) + kap; u32x4 val = {0u, 0u, 0u, 0u};
        if (lp >= 0) val = *(const u32x4*)(Pk + ((size_t)b * T_ + (size_t)lp * d + r) * AD_ + hh * 64 + part * 8);
        const int row = (kap & 0xE0) | (((kap >> 2) & 1) << 4) | (((kap >> 3) & 3) << 2) | (kap & 3);
        *(u32x4*)(Ksh + row * 144 + part * 16) = val;
    }
#pragma unroll
    for (int i = 0; i < 4; ++i) {
        const int chunk = tid + 512 * i, e = chunk >> 5, part = chunk & 31, k0 = part * 8;
        u32x4 val = {0u, 0u, 0u, 0u};
        if (n > 0 || k0 >= 128) val = *(const u32x4*)(VT + (size_t)e * T_ + r * L + 128 * (n - 1) + k0);
        *(u32x4*)(Vsh + e * 528 + part * 16) = val;
    }
    const int q = 16 * wave + qn; const size_t qtok = (size_t)b * T_ + (size_t)(128 * n + q) * d + r;
    const bf16x8 Q0 = *(const bf16x8*)(Pq + qtok * AD_ + hh * 64 + gq * 8), Q1 = *(const bf16x8*)(Pq + qtok * AD_ + hh * 64 + 32 + gq * 8);
    __syncthreads();
    const int s0 = wave >> 1;
    f32x4 sacc[5][2];
#pragma unroll
    for (int st = 0; st < 5; ++st)
#pragma unroll
        for (int bb = 0; bb < 2; ++bb) {
            const int row = (s0 + st) * 32 + bb * 16 + qn;
            const bf16x8 K0 = *(const bf16x8*)(Ksh + row * 144 + gq * 16), K1 = *(const bf16x8*)(Ksh + row * 144 + 64 + gq * 16);
            f32x4 a = {0.f, 0.f, 0.f, 0.f};
            a = __builtin_amdgcn_mfma_f32_16x16x32_bf16(K0, Q0, a, 0, 0, 0);
            a = __builtin_amdgcn_mfma_f32_16x16x32_bf16(K1, Q1, a, 0, 0, 0);
            sacc[st][bb] = a;
        }
    const float SC = 0.125f * 1.4426950408889634f;
    float mx = -INFINITY;
#pragma unroll
    for (int st = 0; st < 5; ++st)
#pragma unroll
        for (int bb = 0; bb < 2; ++bb)
#pragma unroll
            for (int i = 0; i < 4; ++i) {
                const int kap = 32 * (s0 + st) + 8 * gq + 4 * bb + i, rel = q + 128 - kap;
                const bool valid = (rel >= 0) && (rel <= 128) && (n > 0 || kap >= 128);
                const float sv = valid ? sacc[st][bb][i] * SC : -INFINITY;
                sacc[st][bb][i] = sv; mx = fmaxf(mx, sv);
            }
    mx = fmaxf(mx, __shfl_xor(mx, 16)); mx = fmaxf(mx, __shfl_xor(mx, 32));
    float den = 0.f; bf16x8 Pf[5];
#pragma unroll
    for (int st = 0; st < 5; ++st) {
        float pv[8];
#pragma unroll
        for (int bb = 0; bb < 2; ++bb)
#pragma unroll
            for (int i = 0; i < 4; ++i) { const float pe = __builtin_amdgcn_exp2f(sacc[st][bb][i] - mx); pv[bb * 4 + i] = pe; den += pe; }
        u32x4 w; w.x = cvt_pk_bf16(pv[0], pv[1]); w.y = cvt_pk_bf16(pv[2], pv[3]); w.z = cvt_pk_bf16(pv[4], pv[5]); w.w = cvt_pk_bf16(pv[6], pv[7]);
        Pf[st] = __builtin_bit_cast(bf16x8, w);
    }
    den += __shfl_xor(den, 16); den += __shfl_xor(den, 32);
    f32x4 oacc[4];
#pragma unroll
    for (int et = 0; et < 4; ++et) oacc[et] = (f32x4){0.f, 0.f, 0.f, 0.f};
#pragma unroll
    for (int st = 0; st < 5; ++st)
#pragma unroll
        for (int et = 0; et < 4; ++et) {
            const bf16x8 Vf = *(const bf16x8*)(Vsh + (16 * et + qn) * 528 + ((s0 + st) * 32 + 8 * gq) * 2);
            oacc[et] = __builtin_amdgcn_mfma_f32_16x16x32_bf16(Vf, Pf[st], oacc[et], 0, 0, 0);
        }
    const float inv = 1.0f / den;
#pragma unroll
    for (int et = 0; et < 4; ++et) {
        u32x2 w; w.x = cvt_pk_bf16(oacc[et][0] * inv, oacc[et][1] * inv); w.y = cvt_pk_bf16(oacc[et][2] * inv, oacc[et][3] * inv);
        *(u32x2*)(Og + qtok * AD_ + hh * 64 + 16 * et + 4 * gq) = w;
    }
    if (gq == 0) lse[qtok * NHA_ + hh] = mx * 0.6931471805599453f + logf(den);
}

__device__ void phase_scan_attn(const Params& p, unsigned char* lds, int bid, int G) {
    constexpr int NSCAN = 160, NITEM = 3 * 1536;
    int cidx, cn;
    if (G > NSCAN) {
        if (bid < NSCAN) { const int xcd = bid & 7, slot = bid >> 3; scan_unit(p, lds, xcd * 5 + (slot >> 2), slot & 3); cidx = -1; cn = 1; }
        else { for (int it = bid - NSCAN; it < NITEM; it += G - NSCAN) attn_item(p, lds, it); cidx = bid - NSCAN; cn = G - NSCAN; }
    } else {
        for (int u = bid; u < NSCAN; u += G) scan_unit(p, lds, u >> 2, u & 3);
        for (int it = bid; it < NITEM; it += G) attn_item(p, lds, it);
        cidx = bid; cn = G;
    }
    __syncthreads();
    if (cidx >= 0) {
        convert_weight(p.in[29], FF_, D_, (bf16_t*)(p.ws + WS_WIN), FF_, 0, (float*)lds, cidx, cn);
        convert_weight(p.in[24], D_, D_, (bf16_t*)(p.ws + WS_WOUT), LDY_, 0, (float*)lds, cidx, cn);
    }
    __syncthreads();
}

__device__ void phase_post(const Params& p, int bid, int G) {
    const int tid = tidx(), wave = tid >> 6, lane = tid & 63, cgp = lane & 15;
    const bf16_t* Prkv = (const bf16_t*)(p.ws + WS_PRKV); const bf16_t* La = (const bf16_t*)(p.ws + WS_LA); const bf16_t* Lg = (const bf16_t*)(p.ws + WS_LG);
    const bf16_t* Ys = (const bf16_t*)(p.ws + WS_Y); bf16_t* YY = (bf16_t*)((unsigned char*)p.out + DO_YY);
    {
        const int gw = bid * 8 + wave, nslot = (G * 8) / 5;
        if (gw < nslot * 5) {
            const int hg = gw % 5, ch = hg * 256 + lane * 4;
            const f32x4 mu_r = *(const f32x4*)(p.in[8] + ch), mu_k = *(const f32x4*)(p.in[9] + ch), mu_v = *(const f32x4*)(p.in[10] + ch);
            const f32x4 k_a = *(const f32x4*)(p.in[20] + ch), r_k = *(const f32x4*)(p.in[21] + ch), gng = *(const f32x4*)(p.in[22] + ch), gnb = *(const f32x4*)(p.in[23] + ch);
#define PO_LOAD(t, S) u32x2 S##rr, S##kr, S##vr, S##rp = {0u, 0u}, S##kp = {0u, 0u}, S##vp = {0u, 0u}, S##a2, S##g2, S##y2; { const bf16_t* pr = Prkv + (size_t)(t) * 3840 + ch; \
                S##rr = *(const u32x2*)pr; S##kr = *(const u32x2*)(pr + 1280); S##vr = *(const u32x2*)(pr + 2560); \
                if (((t) % T_) > 0) { S##rp = *(const u32x2*)(pr - 3840); S##kp = *(const u32x2*)(pr - 3840 + 1280); S##vp = *(const u32x2*)(pr - 3840 + 2560); } \
                S##a2 = *(const u32x2*)(La + (size_t)(t) * 1280 + ch); S##g2 = *(const u32x2*)(Lg + (size_t)(t) * 1280 + ch); S##y2 = *(const u32x2*)(Ys + (size_t)(t) * 1280 + ch); }
#define PO_UNP(w) ((f32x4){bflo(w.x), bfhi(w.x), bflo(w.y), bfhi(w.y)})
#define PO_COMP(t, S) { const f32x4 r0 = PO_UNP(S##rr), r1 = PO_UNP(S##rp), k0 = PO_UNP(S##kr), k1 = PO_UNP(S##kp), v0 = PO_UNP(S##vr), v1 = PO_UNP(S##vp), av = PO_UNP(S##a2), gv = PO_UNP(S##g2), yv = PO_UNP(S##y2); \
                const f32x4 r = r0 + (r1 - r0) * mu_r, k = k0 + (k1 - k0) * mu_k, v = v0 + (v1 - v0) * mu_v; \
                const f32x4 k2 = k * (1.0f + (av - 1.0f) * k_a); const f32x4 rk4 = r * k2 * r_k; \
                const float rk = red16((rk4[0] + rk4[1]) + (rk4[2] + rk4[3])); \
                const float mu = red16((yv[0] + yv[1]) + (yv[2] + yv[3])) * (1.0f / 64.0f); const f32x4 yc = yv - mu; \
                const float var = red16((yc[0] * yc[0] + yc[1] * yc[1]) + (yc[2] * yc[2] + yc[3] * yc[3])) * (1.0f / 64.0f); \
                const float rstd = 1.0f / sqrtf(var + GN_EPS_); const f32x4 o = (yc * rstd * gng + gnb + v * rk) * gv; \
                u32x2 w; w.x = cvt_pk_bf16(o[0], o[1]); w.y = cvt_pk_bf16(o[2], o[3]); *(u32x2*)(YY + (size_t)(t) * LDY_ + ch) = w; }
            for (int t = gw / 5; t < M_; t += 2 * nslot) {
                const int tb = t + nslot; const bool hasb = tb < M_; const int tbc = hasb ? tb : t;
                PO_LOAD(t, A_); PO_LOAD(tbc, B_);
                PO_COMP(t, A_);
                if (hasb) PO_COMP(tb, B_);
            }
#undef PO_LOAD
#undef PO_UNP
#undef PO_COMP
        }
    }
    const bf16_t* Og = (const bf16_t*)(p.ws + WS_O); const float* lse = (const float*)(p.ws + WS_LSE);
    for (int task = bid * 8 + wave; task < M_ * 3; task += G * 8) {
        const int t = task / 3, hg = task % 3, hh = hg * 4 + (lane >> 4), c = hh * 64 + cgp * 4;
        const float l0 = lse[(size_t)t * NHA_ + hh], l1 = lse[(size_t)M_ * NHA_ + (size_t)t * NHA_ + hh], l2 = lse[(size_t)2 * M_ * NHA_ + (size_t)t * NHA_ + hh];
        const float lm = fmaxf(l0, fmaxf(l1, l2)); const float e0 = __expf(l0 - lm), e1 = __expf(l1 - lm), e2 = __expf(l2 - lm); const float inv = 1.0f / (e0 + e1 + e2);
        const u32x2 o0 = *(const u32x2*)(Og + (size_t)t * AD_ + c), o1 = *(const u32x2*)(Og + (size_t)M_ * AD_ + (size_t)t * AD_ + c), o2 = *(const u32x2*)(Og + (size_t)2 * M_ * AD_ + (size_t)t * AD_ + c);
        const f32x4 a0 = {bflo(o0.x), bfhi(o0.x), bflo(o0.y), bfhi(o0.y)}, a1 = {bflo(o1.x), bfhi(o1.x), bflo(o1.y), bfhi(o1.y)}, a2 = {bflo(o2.x), bfhi(o2.x), bflo(o2.y), bfhi(o2.y)};
        const f32x4 o = (a0 * e0 + a1 * e1 + a2 * e2) * inv;
        u32x2 w; w.x = cvt_pk_bf16(o[0], o[1]); w.y = cvt_pk_bf16(o[2], o[3]);
        *(u32x2*)(YY + (size_t)t * LDY_ + RW_ + c) = w;
    }
}

__global__ void __launch_bounds__(512, 2) fwd_kernel(Params p) {
    extern __shared__ __attribute__((aligned(16))) unsigned char lds_raw[];
    cg::grid_group grid = cg::this_grid();
    LAS unsigned char* ldsl = (LAS unsigned char*)lds_raw;
    const int bid = blockIdx.x, G = gridDim.x;
    unsigned char* ws = p.ws;
    const int lo = p.ph_lo, hi = p.ph_hi;
#define IN(k) (lo <= (k) && (k) < hi)
#define GSYNC() do { grid.sync(); } while (0)
#define SEAM(k) do { if (IN(k) && IN((k) + 1)) GSYNC(); } while (0)
    bf16_t* Xb = (bf16_t*)(ws + WS_XB); bf16_t* Hh = (bf16_t*)(ws + WS_H); float* Hf = (float*)(ws + WS_HF);
    bf16_t* Wgu = (bf16_t*)(ws + WS_WGU); bf16_t* Wd = (bf16_t*)(ws + WS_WD);

    if (IN(0)) { phase_convert0(p, lds_raw, bid, G); } SEAM(0);
    if (IN(1)) { pg8::Gemm g{Xb, Wgu, M_, 2 * FF_, D_, D_, D_}; pg8::StaticOrder S; S.init(M_, 2 * FF_, G, bid); EpiSwiGLU E{Hh, FF_}; pg8::gemm_phase(ldsl, g, S, E); } SEAM(1);
    if (IN(2)) { pg8::Gemm g{Hh, Wd, M_, D_, FF_, FF_, FF_}; pg8::StaticOrder S; S.init(M_, D_, G, bid); EpiRes E{p.out, p.in[0], D_, ALPHA_, 0.5f}; pg8::gemm_phase(ldsl, g, S, E); } SEAM(2);
    if (IN(3)) { ln_phase(p.out, p.in[5], p.in[6], Hf, Xb, bid, G); } SEAM(3);
    if (IN(4)) {
        pg8::Gemm g{Xb, (bf16_t*)(ws + WS_WIN), M_, NIN_, D_, D_, D_}; pg8::StaticOrder S; S.init(M_, NIN_, G, bid);
        EpiWin E{ws, (long)((unsigned char*)p.out - ws)};
        pg8::gemm_phase(ldsl, g, S, E);
    } SEAM(4);
    if (IN(5)) { phase_prep(p, lds_raw, bid, G); } SEAM(5);
    if (IN(6)) { lora_phase(p, lds_raw, 0, 2, bid, G); } SEAM(6);
    if (IN(7)) { phase_scan_attn(p, lds_raw, bid, G); } SEAM(7);
    if (IN(8)) { lora_phase(p, lds_raw, 2, 3, bid, G); } SEAM(8);
    if (IN(9)) { phase_post(p, bid, G); } SEAM(9);
    if (IN(10)) { pg8::Gemm g{(bf16_t*)((unsigned char*)p.out + DO_YY), (bf16_t*)(ws + WS_WOUT), M_, D_, D_, LDY_, LDY_}; pg8::StaticOrder S; S.init(M_, D_, G, bid); EpiRes E{(float*)(ws + WS_Z2), Hf, D_, ALPHA_, 1.0f}; pg8::gemm_phase(ldsl, g, S, E); } SEAM(10);
    if (IN(11)) { ln_phase((const float*)(ws + WS_Z2), p.in[25], p.in[26], Hf, Xb, bid, G); convert_ffn_weights(p, 27, 28, 29, (float*)lds_raw, bid, G, false); } SEAM(11);
    if (IN(12)) { pg8::Gemm g{Xb, Wgu, M_, 2 * FF_, D_, D_, D_}; pg8::StaticOrder S; S.init(M_, 2 * FF_, G, bid); EpiSwiGLU E{Hh, FF_}; pg8::gemm_phase(ldsl, g, S, E); } SEAM(12);
    if (IN(13)) { pg8::Gemm g{Hh, (bf16_t*)(ws + WS_WIN), M_, D_, FF_, FF_, FF_}; pg8::StaticOrder S; S.init(M_, D_, G, bid); EpiRes E{p.out, Hf, D_, ALPHA_, 0.5f}; pg8::gemm_phase(ldsl, g, S, E); } SEAM(13);
    if (IN(14)) { ln_phase(p.out, p.in[30], p.in[31], p.out, nullptr, bid, G); }
#undef IN
#undef SEAM
}

extern "C" void kernel_launch(void* const* d_in, const int* in_sizes, int n_in, void* d_out, int out_size, void* d_ws, size_t ws_size, hipStream_t stream) {
    static int grid_blocks = 0;
    if (grid_blocks == 0) {
        int dev = 0, cus = 0, per_cu = 0;
        hipGetDevice(&dev);
        hipDeviceGetAttribute(&cus, hipDeviceAttributeMultiprocessorCount, dev);
        if (hipFuncSetAttribute((const void*)fwd_kernel, hipFuncAttributeMaxDynamicSharedMemorySize, LDS_BYTES) != hipSuccess) { fprintf(stderr, "hipFuncSetAttribute failed\n"); }
        if (hipOccupancyMaxActiveBlocksPerMultiprocessor(&per_cu, (const void*)fwd_kernel, 512, LDS_BYTES) != hipSuccess || per_cu < 1) { fprintf(stderr, "occupancy query: %d\n", per_cu); per_cu = 1; }
        (void)hipGetLastError();
        grid_blocks = cus * 1;
        if (ws_size < 512 * MiB || n_in != 32) fprintf(stderr, "kernel_launch: unexpected ws_size %zu / n_in %d\n", ws_size, n_in);
    }
    Params p{};
    for (int i = 0; i < 32; ++i) p.in[i] = (const float*)d_in[i];
    p.out = (float*)d_out; p.ws = (unsigned char*)d_ws;
#if N_LAUNCH_MODE == 1
    p.ph_lo = 0; p.ph_hi = NPHASE;
    void* args[] = {&p};
    hipError_t e = hipLaunchCooperativeKernel((const void*)fwd_kernel, dim3(grid_blocks), dim3(512), args, LDS_BYTES, stream);
    if (e != hipSuccess) fprintf(stderr, "cooperative launch failed: %s (grid %d)\n", hipGetErrorString(e), grid_blocks);
#else
    for (int ph = 0; ph < NPHASE; ++ph) {
        p.ph_lo = ph; p.ph_hi = ph + 1;
        void* args[] = {&p};
        hipError_t e = hipLaunchCooperativeKernel((const void*)fwd_kernel, dim3(grid_blocks), dim3(512), args, LDS_BYTES, stream);
        if (e != hipSuccess) { fprintf(stderr, "launch %d failed: %s (grid %d)\n", ph, hipGetErrorString(e), grid_blocks); break; }
    }
#endif
}
```
